# Optimizing an MI355X kernel written in HIP

```python
import jax, jax.numpy as jnp
from jax import lax
import numpy as np

D_MODEL = 1024
BATCH = 32
SEQ = 2048
DEPTH = 1

D_RNN = 1280
N_RNN_BLOCKS = 10
RNN_BLOCK = D_RNN // N_RNN_BLOCKS
RNN_CONV_WIDTH = 4
LRU_C = 8.0
N_HEADS = 8
HEAD_DIM = 128
D_ATTN = N_HEADS * HEAD_DIM
Q_BLOCK = 128
D_FF = 3 * D_MODEL
FFN_CONV_WIDTH = 3
RMS_EPS = 1e-6
SPLIT_SIZES = (D_RNN, D_RNN, D_ATTN, D_ATTN, D_ATTN, N_HEADS, 2 * D_MODEL)
D_IN = sum(SPLIT_SIZES)
N_MOD = 6

kernel_name = "hybrid_rglru_fox_convffn_adaln"


def rmsnorm(x, g):
    xf = x.astype(jnp.float32)
    y = xf * lax.rsqrt(jnp.mean(xf * xf, axis=-1, keepdims=True) + RMS_EPS)
    return (y * g.astype(jnp.float32)).astype(x.dtype)


def modulate(h, shift, scale):
    return h * (1 + scale[:, None, :]) + shift[:, None, :]


def causal_dwconv(x, w, b):
    K = w.shape[0]
    S = x.shape[1]
    xp = jnp.pad(x, ((0, 0), (K - 1, 0), (0, 0)))
    y = b
    for k in range(K):
        y = y + xp[:, k:k + S, :] * w[k]
    return y


def block_diag_linear(x, w, b):
    B, S, _ = x.shape
    xb = x.reshape(B, S, N_RNN_BLOCKS, RNN_BLOCK)
    return jnp.einsum('bsnc,ncd->bsnd', xb, w).reshape(B, S, D_RNN) + b


def rg_lru(x, w_a, b_a, w_i, b_i, lam):
    r = jax.nn.sigmoid(block_diag_linear(x, w_a, b_a)).astype(jnp.float32)
    i = jax.nn.sigmoid(block_diag_linear(x, w_i, b_i))
    log_a = -LRU_C * r * jax.nn.softplus(-lam.astype(jnp.float32))
    a = jnp.exp(log_a)
    mult = jnp.sqrt(-jnp.expm1(2.0 * log_a))
    u = mult * (i * x).astype(jnp.float32)

    def combine(left, right):
        a_l, b_l = left
        a_r, b_r = right
        return a_l * a_r, a_r * b_l + b_r

    _, h = lax.associative_scan(combine, (a, u), axis=1)
    return h.astype(x.dtype)


def forgetting_attention(q, k, v, log_f):
    B, S, H, Dh = q.shape
    F = jnp.cumsum(log_f, axis=1).transpose(0, 2, 1)
    qh = (q * (Dh ** -0.5)).transpose(0, 2, 1, 3)
    kh = k.transpose(0, 2, 1, 3)
    vh = v.transpose(0, 2, 1, 3)
    outs = []
    for blk in range(S // Q_BLOCK):
        q0 = blk * Q_BLOCK
        q1 = q0 + Q_BLOCK
        s = jnp.einsum('bhqd,bhkd->bhqk', qh[:, :, q0:q1], kh[:, :, :q1],
                       preferred_element_type=jnp.float32)
        s = s + F[:, :, q0:q1, None] - F[:, :, None, :q1]
        mask = (q0 + jnp.arange(Q_BLOCK))[:, None] >= jnp.arange(q1)[None, :]
        s = jnp.where(mask, s, -jnp.inf)
        p = jax.nn.softmax(s, axis=-1)
        outs.append(jnp.einsum('bhqk,bhkd->bhqd', p.astype(vh.dtype), vh[:, :, :q1]))
    o = jnp.concatenate(outs, axis=2)
    return o.transpose(0, 2, 1, 3).reshape(B, S, H * Dh)


def setup_inputs(seed: int = 0) -> dict:
    key = jax.random.key(seed)
    ks = iter(jax.random.split(key, 40))
    nrm = lambda shape, s: jax.random.normal(next(ks), shape, jnp.float32) * s
    L = DEPTH
    a0 = jax.random.uniform(next(ks), (L, D_RNN), jnp.float32, 0.9, 0.999)
    return {
        "x": nrm((BATCH, SEQ, D_MODEL), 1.0),
        "c": nrm((BATCH, D_MODEL), 1.0),
        "w_ada": nrm((L, D_MODEL, N_MOD * D_MODEL), D_MODEL ** -0.5),
        "b_ada": nrm((L, N_MOD * D_MODEL), 0.01),
        "g_norm1": 1.0 + nrm((L, D_MODEL), 0.02),
        "w_in": nrm((L, D_MODEL, D_IN), D_MODEL ** -0.5),
        "w_rnn_conv": nrm((L, RNN_CONV_WIDTH, D_RNN), RNN_CONV_WIDTH ** -0.5),
        "b_rnn_conv": nrm((L, D_RNN), 0.01),
        "w_lru_a": nrm((L, N_RNN_BLOCKS, RNN_BLOCK, RNN_BLOCK), RNN_BLOCK ** -0.5),
        "b_lru_a": nrm((L, D_RNN), 0.01),
        "w_lru_i": nrm((L, N_RNN_BLOCKS, RNN_BLOCK, RNN_BLOCK), RNN_BLOCK ** -0.5),
        "b_lru_i": nrm((L, D_RNN), 0.01),
        "lru_lambda": jnp.log(a0) - jnp.log1p(-a0),
        "b_fgate": 3.0 + nrm((L, N_HEADS), 0.1),
        "w_proj_rnn": nrm((L, D_RNN, D_MODEL), D_RNN ** -0.5),
        "w_proj_attn": nrm((L, D_ATTN, D_MODEL), D_ATTN ** -0.5),
        "w_out": nrm((L, D_MODEL, D_MODEL), D_MODEL ** -0.5),
        "g_norm2": 1.0 + nrm((L, D_MODEL), 0.02),
        "w_ffn_up": nrm((L, D_MODEL, 2 * D_FF), D_MODEL ** -0.5),
        "w_ffn_conv": nrm((L, FFN_CONV_WIDTH, D_FF), FFN_CONV_WIDTH ** -0.5),
        "b_ffn_conv": nrm((L, D_FF), 0.01),
        "w_ffn_down": nrm((L, D_FF, D_MODEL), D_FF ** -0.5),
        "w_ada_final": nrm((D_MODEL, 2 * D_MODEL), D_MODEL ** -0.5),
        "b_ada_final": nrm((2 * D_MODEL,), 0.01),
        "g_final": 1.0 + nrm((D_MODEL,), 0.02),
    }


def reference(x, c, w_ada, b_ada, g_norm1, w_in, w_rnn_conv, b_rnn_conv, w_lru_a, b_lru_a,
              w_lru_i, b_lru_i, lru_lambda, b_fgate, w_proj_rnn, w_proj_attn, w_out, g_norm2,
              w_ffn_up, w_ffn_conv, b_ffn_conv, w_ffn_down, w_ada_final, b_ada_final, g_final):
    B, S, _ = x.shape
    c_act = jax.nn.silu(c)
    split_idx = [int(v) for v in np.cumsum(SPLIT_SIZES)[:-1]]
    for l in range(DEPTH):
        mod = c_act @ w_ada[l] + b_ada[l]
        shift1, scale1, gate1, shift2, scale2, gate2 = jnp.split(mod, N_MOD, axis=-1)

        h = modulate(rmsnorm(x, g_norm1[l]), shift1, scale1)
        z = h @ w_in[l]
        xr, gr, q, k, v, fl, mg = jnp.split(z, split_idx, axis=-1)

        xr = causal_dwconv(xr, w_rnn_conv[l], b_rnn_conv[l])
        hr = rg_lru(xr, w_lru_a[l], b_lru_a[l], w_lru_i[l], b_lru_i[l], lru_lambda[l])
        y_rnn = jax.nn.gelu(gr, approximate=True) * hr

        log_f = jax.nn.log_sigmoid(fl.astype(jnp.float32) + b_fgate[l].astype(jnp.float32))
        y_attn = forgetting_attention(q.reshape(B, S, N_HEADS, HEAD_DIM),
                                      k.reshape(B, S, N_HEADS, HEAD_DIM),
                                      v.reshape(B, S, N_HEADS, HEAD_DIM), log_f)

        g_r, g_a = jnp.split(jax.nn.sigmoid(mg), 2, axis=-1)
        merged = g_r * (y_rnn @ w_proj_rnn[l]) + g_a * (y_attn @ w_proj_attn[l])
        x = x + gate1[:, None, :] * (merged @ w_out[l])

        h = modulate(rmsnorm(x, g_norm2[l]), shift2, scale2)
        gf, uf = jnp.split(h @ w_ffn_up[l], 2, axis=-1)
        gf = causal_dwconv(gf, w_ffn_conv[l], b_ffn_conv[l])
        y_ffn = (jax.nn.gelu(gf, approximate=True) * uf) @ w_ffn_down[l]
        x = x + gate2[:, None, :] * y_ffn

    shift_f, scale_f = jnp.split(c_act @ w_ada_final + b_ada_final, 2, axis=-1)
    return modulate(rmsnorm(x, g_final), shift_f, scale_f)
```

```cpp
#include <hip/hip_runtime.h>
#include <hip/hip_bf16.h>
#include <hip/hip_cooperative_groups.h>
#include <cstdio>
#include <cstdint>
#include <cstddef>
namespace pg8 {
#define PG8_LAS __attribute__((address_space(3)))
typedef unsigned short bf16_t;
typedef short bf16x8 __attribute__((ext_vector_type(8)));
typedef float f32x4 __attribute__((ext_vector_type(4)));
typedef unsigned u32x4 __attribute__((ext_vector_type(4)));
constexpr int BM = 256, BK = 64, HALF = 128, HTB = HALF * BK * 2  , STAGE_BYTES = 8 * HTB, NXCD = 8, WGM = 8;

__host__ __device__ __forceinline__ int lds_byte(int r, int c) { const int st = (r >> 4) * 2 + (c >> 5), rr = r & 15, cc = c & 31, ob = rr * 64 + cc * 2; return st * 1024 + (ob ^ (((ob >> 9) & 1) << 5)); }
__host__ __device__ __forceinline__ void stage_rc(int b, int& R, int& C) { const int st = b / 1024, sb = b % 1024, swz = sb ^ (((sb >> 9) & 1) << 5); R = (st >> 1) * 16 + swz / 64; C = (st & 1) * 32 + (swz % 64) / 2; }
__host__ __device__ __forceinline__ int perm32(int rho) { const int n = rho >> 4, i = rho & 15; return 8 * (i >> 2) + 4 * n + (i & 3); }

struct Unit { int pm, pn; };
struct Gemm { const bf16_t* A; const bf16_t* Bt; int M, N, K; };

struct StaticOrder {
    int nM, nN, nwg, G, c;
    __host__ __device__ void init(int M, int N, int G_, int c_) { nM = M / BM; nN = N / BM; nwg = nM * nN; G = G_; c = c_; }
    __host__ __device__ bool next(int i, Unit& u) const {
        const long L = (long)i * G + c; if (L >= nwg) return false;
        int wgid = (int)L; { const int q = nwg / NXCD, r = nwg % NXCD, xcd = wgid % NXCD, off = wgid / NXCD; wgid = (xcd < r ? xcd * (q + 1) : r * (q + 1) + (xcd - r) * q) + off; }
        const int nig = WGM * nN, gid = wgid / nig, fm = gid * WGM, gsz = (nM - fm) < WGM ? (nM - fm) : WGM;
        u.pm = fm + ((wgid % nig) % gsz); u.pn = (wgid % nig) / gsz; return true;
    }
    __device__ __forceinline__ void a_ready(const Unit&) const {}
    __device__ __forceinline__ void done(const Unit&) const {}
};

__device__ __forceinline__ unsigned cvt_pk_bf16(float lo, float hi) { unsigned r; asm volatile("v_cvt_pk_bf16_f32 %0, %1, %2" : "=v"(r) : "v"(lo), "v"(hi)); return r; }
typedef float f32x2 __attribute__((ext_vector_type(2)));
__device__ __forceinline__ float sigmoidf_(float x) { return __builtin_amdgcn_rcpf(1.0f + __builtin_amdgcn_exp2f(-1.4426950408889634f * x)); }
__device__ __forceinline__ float bf_lo(unsigned w) { return __uint_as_float(w << 16); }
__device__ __forceinline__ float bf_hi(unsigned w) { return __uint_as_float(w & 0xffff0000u); }

constexpr size_t EMiB = 1u << 20, E_XR = 192 * EMiB, E_GR = 352 * EMiB, E_Q = 512 * EMiB, E_K = 640 * EMiB, E_V = 768 * EMiB, E_GF = 192 * EMiB, E_UF = 576 * EMiB;
template <int MODE, int WHICH = 0> struct EpiB {
    static constexpr bool PERM = true, AFTER_DRAIN = false;
    bf16_t* s0; int l0;
    unsigned char* ws; bf16_t* mg;
    const bf16_t* G; int g_ld, gcol;
    __device__ __forceinline__ void operator()(const f32x4 (&acc)[2][2][4][2], const Unit& u, int wr, int wc, int fr, int fq) const {
        const int row0 = u.pm * BM + wr * 64 + fr; int colt = u.pn * BM; bf16_t* base = s0; int ldc = l0;
        if (MODE == 0) {
            const int pn = u.pn; size_t off; int tl;
            if (WHICH == 0) {
                if (pn < 5) { off = E_XR; ldc = 1280; tl = pn; } else if (pn < 10) { off = E_GR; ldc = 1280; tl = pn - 5; } else if (pn < 14) { off = E_Q; ldc = 1024; tl = pn - 10; }
                else if (pn < 18) { off = E_K; ldc = 1024; tl = pn - 14; } else if (pn < 22) { off = E_V; ldc = 1024; tl = pn - 18; } else { off = 0; ldc = 2048; tl = pn - 22; }
                base = (pn >= 22) ? mg : (bf16_t*)(ws + off);
            } else {
                if (pn < 12) { off = E_GF; tl = pn; } else { off = E_UF; tl = pn - 12; }
                ldc = 3072; base = (bf16_t*)(ws + off);
            }
            colt = tl * BM;
        }
        const int col0 = colt + wc * 32 + 8 * fq;
#pragma unroll
        for (int ai = 0; ai < 2; ++ai)
#pragma unroll
            for (int m = 0; m < 4; ++m) { const int row = row0 + ai * HALF + m * 16; bf16_t* rowp = base + (size_t)row * ldc + col0;
#pragma unroll
                for (int bj = 0; bj < 2; ++bj) { f32x4 v0 = acc[ai][bj][m][0], v1 = acc[ai][bj][m][1];
                    if (MODE >= 1) {
                        const u32x4 gw = *(const u32x4*)(G + (size_t)row * g_ld + gcol + col0 + bj * HALF);
                        v0[0] *= sigmoidf_(bf_lo(gw.x)); v0[1] *= sigmoidf_(bf_hi(gw.x)); v0[2] *= sigmoidf_(bf_lo(gw.y)); v0[3] *= sigmoidf_(bf_hi(gw.y));
                        v1[0] *= sigmoidf_(bf_lo(gw.z)); v1[1] *= sigmoidf_(bf_hi(gw.z)); v1[2] *= sigmoidf_(bf_lo(gw.w)); v1[3] *= sigmoidf_(bf_hi(gw.w));
                    }
                    if (MODE == 2) {
                        const u32x4 ow = *(const u32x4*)(rowp + bj * HALF);
                        v0[0] += bf_lo(ow.x); v0[1] += bf_hi(ow.x); v0[2] += bf_lo(ow.y); v0[3] += bf_hi(ow.y);
                        v1[0] += bf_lo(ow.z); v1[1] += bf_hi(ow.z); v1[2] += bf_lo(ow.w); v1[3] += bf_hi(ow.w);
                    }
                    u32x4 w; w.x = cvt_pk_bf16(v0[0], v0[1]); w.y = cvt_pk_bf16(v0[2], v0[3]); w.z = cvt_pk_bf16(v1[0], v1[1]); w.w = cvt_pk_bf16(v1[2], v1[3]);
                    *(u32x4*)(rowp + bj * HALF) = w; } }
    }
};
struct EpiRes {
    static constexpr bool PERM = false, AFTER_DRAIN = false;
    const float* base; float* out; const float* gate; int gate_ld; int ldc;
    __device__ __forceinline__ void operator()(const f32x4 (&acc)[2][2][4][2], const Unit& u, int wr, int wc, int fr, int fq) const {
        const int row0 = u.pm * BM + wr * 64 + fr, col0 = u.pn * BM + wc * 32 + 4 * fq;
        const float* gp = gate + (size_t)(u.pm >> 3) * gate_ld + col0;
        f32x4 gv[2][2];
#pragma unroll
        for (int bj = 0; bj < 2; ++bj)
#pragma unroll
            for (int n = 0; n < 2; ++n) gv[bj][n] = *(const f32x4*)(gp + bj * HALF + n * 16);
#pragma unroll
        for (int ai = 0; ai < 2; ++ai)
#pragma unroll
            for (int m = 0; m < 4; ++m) { const size_t off = (size_t)(row0 + ai * HALF + m * 16) * ldc + col0;
#pragma unroll
                for (int bj = 0; bj < 2; ++bj)
#pragma unroll
                    for (int n = 0; n < 2; ++n) { const f32x4 bs = *(const f32x4*)(base + off + bj * HALF + n * 16);
                        *(f32x4*)(out + off + bj * HALF + n * 16) = bs + gv[bj][n] * acc[ai][bj][m][n]; } }
    }
};
template <class Epi, class Sched, bool ALIGN_EPI = false, bool SP2 = false>
__device__ __forceinline__ void gemm_phase(PG8_LAS unsigned char* lds, const Gemm g, const Sched& S, const Epi& E) {
    const int tid = threadIdx.x, wid = __builtin_amdgcn_readfirstlane(tid >> 6), lane = tid & 63, wr = wid >> 2, wc = wid & 3, fr = lane & 15, fq = lane >> 4;
    const int K = g.K, nt = K / BK;
    unsigned voffA[2], voffB[2];
#pragma unroll
    for (int i = 0; i < 2; ++i) { int R, C; stage_rc(tid * 16 + i * 8192, R, C); const int Rb = Epi::PERM ? ((R & ~31) + perm32(R & 31)) : R;
        voffA[i] = (unsigned)(R * K + C) * 2u; voffB[i] = (unsigned)(Rb * K + C) * 2u; }
    const size_t kstep = (size_t)(BK * 2);
    const size_t hstep = (size_t)HALF * K * 2;
    const size_t tstep = 2 * hstep;
    const unsigned ldsw = (unsigned)wid * 1024u;
    const int aoff = lds_byte(wr * 64 + fr, fq * 8), boff = lds_byte(wc * 32 + fr, fq * 8);
#define PG8_SA(b, h) (((b) * 2 + (h)) * HTB)
#define PG8_SB(b, h) ((4 + (b) * 2 + (h)) * HTB)
#define PG8_STAGE(bufoff, gbase, voff) do { _Pragma("unroll") for (int _i = 0; _i < 2; ++_i) \
        __builtin_amdgcn_global_load_lds((const unsigned*)((const char*)(gbase) + (voff)[_i]), (PG8_LAS unsigned*)(lds + (bufoff) + ldsw + _i * 8192), 16, 0, 0); } while (0)
#define PG8_LDA(dst, b, h) do { _Pragma("unroll") for (int m = 0; m < 4; ++m) _Pragma("unroll") for (int k = 0; k < 2; ++k) dst[m][k] = *(const PG8_LAS bf16x8*)(lds + PG8_SA(b, h) + aoff + m * 2048 + k * 1024); } while (0)
#define PG8_LDB(dst, b, h) do { _Pragma("unroll") for (int n = 0; n < 2; ++n) _Pragma("unroll") for (int k = 0; k < 2; ++k) dst[n][k] = *(const PG8_LAS bf16x8*)(lds + PG8_SB(b, h) + boff + n * 2048 + k * 1024); } while (0)
#define PG8_MMA(ai, bj, At, Bt) do { __builtin_amdgcn_s_setprio(1); _Pragma("unroll") for (int m = 0; m < 4; ++m) _Pragma("unroll") for (int n = 0; n < 2; ++n) _Pragma("unroll") for (int k = 0; k < 2; ++k) \
        acc[ai][bj][m][n] = __builtin_amdgcn_mfma_f32_16x16x32_bf16(Bt[n][k], At[m][k], acc[ai][bj][m][n], 0, 0, 0); __builtin_amdgcn_s_setprio(0); } while (0)
#define PG8_WAIT_V(n) asm volatile("s_waitcnt vmcnt(" #n ")" ::: "memory")
#define PG8_WAIT_L(n) asm volatile("s_waitcnt lgkmcnt(" #n ")" ::: "memory")
#define PG8_BAR __builtin_amdgcn_s_barrier()
#define PG8_SCHED __builtin_amdgcn_sched_barrier(0)
    Unit cur, nxt; int ui = 0;
    if (!S.next(0, cur)) return;
    f32x4 acc[2][2][4][2];
#pragma unroll
    for (int a = 0; a < 2; ++a)
#pragma unroll
        for (int b = 0; b < 2; ++b)
#pragma unroll
            for (int m = 0; m < 4; ++m)
#pragma unroll
                for (int n = 0; n < 2; ++n) acc[a][b][m][n] = (f32x4){0.f, 0.f, 0.f, 0.f};
    bf16x8 At[4][2], B0[2][2], B1[2][2];
    const char* cA = (const char*)g.A + (size_t)cur.pm * tstep; const char* cB = (const char*)g.Bt + (size_t)cur.pn * tstep;
    S.a_ready(cur);
    if constexpr (SP2) {
        PG8_STAGE(PG8_SB(0, 0), cB, voffB); PG8_STAGE(PG8_SB(0, 1), cB + hstep, voffB); PG8_STAGE(PG8_SA(0, 0), cA, voffA); PG8_STAGE(PG8_SA(0, 1), cA + hstep, voffA);
        if (wr == 1) PG8_BAR;
        PG8_WAIT_V(2); PG8_BAR;
        PG8_STAGE(PG8_SB(1, 0), cB + kstep, voffB); PG8_STAGE(PG8_SA(1, 0), cA + kstep, voffA); PG8_STAGE(PG8_SB(1, 1), cB + hstep + kstep, voffB);
        PG8_WAIT_V(6); PG8_BAR;
    } else {
        PG8_STAGE(PG8_SB(0, 0), cB, voffB); PG8_STAGE(PG8_SA(0, 0), cA, voffA); PG8_STAGE(PG8_SB(0, 1), cB + hstep, voffB); PG8_STAGE(PG8_SA(0, 1), cA + hstep, voffA);
        if (wr == 1) PG8_BAR;
        PG8_WAIT_V(4); PG8_BAR;
        PG8_STAGE(PG8_SB(1, 0), cB + kstep, voffB); PG8_STAGE(PG8_SA(1, 0), cA + kstep, voffA); PG8_STAGE(PG8_SB(1, 1), cB + hstep + kstep, voffB);
        PG8_WAIT_V(6); PG8_BAR;
    }
    for (;;) {
        const bool has_next = S.next(ui + 1, nxt);
        const char* nA = has_next ? (const char*)g.A + (size_t)nxt.pm * tstep : cA; const char* nB = has_next ? (const char*)g.Bt + (size_t)nxt.pn * tstep : cB;
        for (int t = 0; t < nt; t += 2) {
            const bool last = (t == nt - 2);
            const char* a1 = cA + (size_t)(t + 1) * kstep;
            const char* a2 = last ? nA : cA + (size_t)(t + 2) * kstep; const char* b2 = last ? nB : cB + (size_t)(t + 2) * kstep;
            const char* a3 = a2 + kstep; const char* b3 = b2 + kstep;
            if (last && has_next) S.a_ready(nxt);
            if constexpr (SP2) {
            PG8_LDB(B0, 0, 0); PG8_LDB(B1, 0, 1); PG8_SCHED; PG8_LDA(At, 0, 0); PG8_STAGE(PG8_SA(1, 1), a1 + hstep, voffA);
            PG8_WAIT_V(8); PG8_WAIT_L(0); PG8_BAR; PG8_MMA(0, 0, At, B0); PG8_MMA(0, 1, At, B1); PG8_BAR; PG8_SCHED;
            PG8_LDA(At, 0, 1); PG8_STAGE(PG8_SB(0, 0), b2, voffB); PG8_STAGE(PG8_SB(0, 1), b2 + hstep, voffB); PG8_STAGE(PG8_SA(0, 0), a2, voffA);
            PG8_WAIT_V(8); PG8_WAIT_L(0); PG8_BAR; PG8_MMA(1, 0, At, B0); PG8_MMA(1, 1, At, B1); PG8_BAR; PG8_SCHED;
            PG8_LDB(B0, 1, 0); PG8_LDB(B1, 1, 1); PG8_SCHED; PG8_LDA(At, 1, 0); PG8_STAGE(PG8_SA(0, 1), a2 + hstep, voffA);
            PG8_WAIT_V(8); PG8_WAIT_L(0); PG8_BAR; PG8_MMA(0, 0, At, B0); PG8_MMA(0, 1, At, B1); PG8_BAR; PG8_SCHED;
            PG8_LDA(At, 1, 1); PG8_STAGE(PG8_SB(1, 0), b3, voffB); PG8_STAGE(PG8_SB(1, 1), b3 + hstep, voffB); PG8_STAGE(PG8_SA(1, 0), a3, voffA);
            PG8_WAIT_V(8); PG8_WAIT_L(0); PG8_BAR; PG8_MMA(1, 0, At, B0); PG8_MMA(1, 1, At, B1); PG8_BAR; PG8_SCHED;
            } else {
            PG8_LDB(B0, 0, 0); PG8_SCHED; PG8_LDA(At, 0, 0); PG8_STAGE(PG8_SA(1, 1), a1 + hstep, voffA);
            PG8_WAIT_L(8); PG8_BAR; PG8_WAIT_L(0); PG8_MMA(0, 0, At, B0); PG8_BAR; PG8_SCHED;
            PG8_LDB(B1, 0, 1); PG8_STAGE(PG8_SB(0, 0), b2, voffB);
            PG8_BAR; PG8_WAIT_L(0); PG8_MMA(0, 1, At, B1); PG8_BAR;
            PG8_LDA(At, 0, 1); PG8_STAGE(PG8_SA(0, 0), a2, voffA);
            PG8_BAR; PG8_WAIT_L(0); PG8_MMA(1, 0, At, B0); PG8_BAR; PG8_SCHED;
            PG8_STAGE(PG8_SB(0, 1), b2 + hstep, voffB);
            PG8_WAIT_V(6); PG8_BAR; PG8_MMA(1, 1, At, B1); PG8_BAR;
            PG8_LDB(B0, 1, 0); PG8_SCHED; PG8_LDA(At, 1, 0); PG8_STAGE(PG8_SA(0, 1), a2 + hstep, voffA);
            PG8_WAIT_L(8); PG8_BAR; PG8_WAIT_L(0); PG8_MMA(0, 0, At, B0); PG8_BAR; PG8_SCHED;
            PG8_LDB(B1, 1, 1); PG8_STAGE(PG8_SB(1, 0), b3, voffB);
            PG8_BAR; PG8_WAIT_L(0); PG8_MMA(0, 1, At, B1); PG8_BAR;
            PG8_LDA(At, 1, 1); PG8_STAGE(PG8_SA(1, 0), a3, voffA);
            PG8_BAR; PG8_WAIT_L(0); PG8_MMA(1, 0, At, B0); PG8_BAR; PG8_SCHED;
            PG8_STAGE(PG8_SB(1, 1), b3 + hstep, voffB);
            PG8_WAIT_V(6); PG8_BAR; PG8_MMA(1, 1, At, B1); PG8_BAR;
            }
        }
        if constexpr (ALIGN_EPI) { if (wr == 0) PG8_BAR; }
        if constexpr (!Epi::AFTER_DRAIN) { E(acc, cur, wr, wc, fr, fq); S.done(cur); }
        if (!has_next) break;
#pragma unroll
        for (int a = 0; a < 2; ++a)
#pragma unroll
            for (int b = 0; b < 2; ++b)
#pragma unroll
                for (int m = 0; m < 4; ++m)
#pragma unroll
                    for (int n = 0; n < 2; ++n) acc[a][b][m][n] = (f32x4){0.f, 0.f, 0.f, 0.f};
        cur = nxt; cA = nA; cB = nB; ++ui;
        if constexpr (ALIGN_EPI) { if (wr == 1) PG8_BAR; }
    }
    PG8_WAIT_V(0);
    if constexpr (!ALIGN_EPI) { if (wr == 0) PG8_BAR; }
    PG8_BAR;
    if constexpr (Epi::AFTER_DRAIN) { E.fused(acc, cur, wr, wc, fr, fq, lds, wid, lane); S.done(cur); }
#undef PG8_SA
#undef PG8_SB
#undef PG8_STAGE
#undef PG8_LDA
#undef PG8_LDB
#undef PG8_MMA
#undef PG8_WAIT_V
#undef PG8_WAIT_L
#undef PG8_BAR
#undef PG8_SCHED
}
}
namespace att {
constexpr int D = 128, LDQ = 1024, NW = 8, QBLK = 32, KVBLK = 64, QB = NW * QBLK;
constexpr int SHM_V = KVBLK * D * 2, SHM_K = KVBLK * D * 2;
constexpr int OFF_WS = 2 * SHM_V + 2 * SHM_K, OFF_BIAS = OFF_WS + NW * 64 * 4, OFF_Q = OFF_BIAS + 2 * 64 * 4, LDS_BYTES = OFF_Q + NW * 8192;
constexpr float SCALE = 0.08838834764831845f, THR = 8.f;
typedef unsigned short bf16;
typedef short bf16x8 __attribute__((ext_vector_type(8)));
typedef short s16x4 __attribute__((ext_vector_type(4)));
typedef float f32x16 __attribute__((ext_vector_type(16)));
typedef float f32x4 __attribute__((ext_vector_type(4)));
typedef unsigned u32x4 __attribute__((ext_vector_type(4)));
#define KSWZ(row, colB) ((row) * 256 + ((colB) ^ (((row) & 7) << 4)))
#define SBAR() __builtin_amdgcn_sched_barrier(0)
__device__ __forceinline__ int v_st(int k, int c) { const int kk = (k & ~0xC) | ((k & 4) << 1) | ((k & 8) >> 1); return ((kk >> 3) * 4 + (c >> 5)) * 512 + ((kk & 7) * 32 + (c & 31)) * 2; }
__device__ __forceinline__ int v_rd_base(int lane) { return ((lane & 3) << 3) | (((lane >> 2) & 3) << 6) | (((lane >> 4) & 1) << 5) | (((lane >> 5) & 1) << 8); }
constexpr int v_rd_off(int d0, int ks, int half) { return d0 * 512 + ks * 4096 + half * 2048; }
__device__ __forceinline__ int crow(int r, int hi) { return (r & 3) + 8 * (r >> 2) + 4 * hi; }
__device__ __forceinline__ unsigned cvtpk(float lo, float hi) { unsigned r; asm volatile("v_cvt_pk_bf16_f32 %0, %1, %2" : "=v"(r) : "v"(lo), "v"(hi)); return r; }
__device__ __forceinline__ bf16x8 load8(const bf16* p) { return *reinterpret_cast<const bf16x8*>(p); }
__device__ __forceinline__ void mask_tile(f32x16& p0, f32x16& p1, int dq, unsigned W) {
    const float NEG = -__builtin_inff();
#pragma unroll
    for (int r = 0; r < 16; ++r) {
        const int c = (r & 3) + 8 * (r >> 2);
        if ((unsigned)(dq - c) >= W) p0[r] = NEG;
        if ((unsigned)(dq - c - 32) >= W) p1[r] = NEG;
    }
}
__device__ __forceinline__ void partialSM(f32x16& p0, f32x16& p1, float& m_reg, float& mn, float& alpha) {
    float pmax = p0[0]; for (int r = 1; r < 16; ++r) pmax = fmaxf(pmax, p0[r]); for (int r = 0; r < 16; ++r) pmax = fmaxf(pmax, p1[r]);
    { auto rr = __builtin_amdgcn_permlane32_swap(__float_as_uint(pmax), __float_as_uint(pmax), false, false);
      pmax = fmaxf(__uint_as_float(rr[0]), __uint_as_float(rr[1])); }
    constexpr float C2 = 1.4426950408889634f * SCALE;
    if (__builtin_expect(__all((pmax - m_reg) * SCALE <= THR), 1)) { mn = m_reg; alpha = 1.f; }
    else { mn = fmaxf(m_reg, pmax); alpha = __builtin_amdgcn_exp2f((m_reg - mn) * C2); m_reg = mn; }
    const float mnL = -mn * C2;
    for (int r = 0; r < 16; ++r) p0[r] = fmaf(p0[r], C2, mnL); for (int r = 0; r < 16; ++r) p1[r] = fmaf(p1[r], C2, mnL);
    for (int r = 0; r < 16; ++r) p0[r] = __builtin_amdgcn_exp2f(p0[r]);
}
__device__ __forceinline__ void finishSM(f32x16& p0, f32x16& p1, float alpha, float& l_reg, bf16x8& pa0, bf16x8& pa1, bf16x8& pa2, bf16x8& pa3) {
    for (int r = 0; r < 16; ++r) p1[r] = __builtin_amdgcn_exp2f(p1[r]);
    float ps = 0; for (int r = 0; r < 16; ++r) ps += p0[r]; for (int r = 0; r < 16; ++r) ps += p1[r];
    { auto rr = __builtin_amdgcn_permlane32_swap(__float_as_uint(ps), __float_as_uint(ps), false, false);
      ps = __uint_as_float(rr[0]) + __uint_as_float(rr[1]); }
    l_reg = l_reg * alpha + ps;
#define PK4(P, B_, OUT) do { unsigned a0 = cvtpk(P[B_+0], P[B_+1]), a1 = cvtpk(P[B_+2], P[B_+3]);                          \
        unsigned b0 = cvtpk(P[B_+4], P[B_+5]), b1 = cvtpk(P[B_+6], P[B_+7]);                                             \
        auto r0 = __builtin_amdgcn_permlane32_swap(a0, b0, false, false); auto r1 = __builtin_amdgcn_permlane32_swap(a1, b1, false, false); \
        u32x4 w = {r0[0], r1[0], r0[1], r1[1]}; OUT = *reinterpret_cast<bf16x8*>(&w); } while (0)
    PK4(p0, 0, pa0); PK4(p0, 8, pa1); PK4(p1, 0, pa2); PK4(p1, 8, pa3);
#undef PK4
}
template <int KB>
__device__ __forceinline__ void qkt(f32x16& p0, f32x16& p1, const char* K_lds, const float* bias_l, int r32, int hi, const char* qf) {
    const float* bl = bias_l + KB * 64 + 4 * hi;
#pragma unroll
    for (int g = 0; g < 4; ++g) { const f32x4 t0 = *(const f32x4*)(bl + 8 * g), t1 = *(const f32x4*)(bl + 32 + 8 * g);
#pragma unroll
        for (int i = 0; i < 4; ++i) { p0[4 * g + i] = t0[i]; p1[4 * g + i] = t1[i]; } }
    const char* kb[4];
#pragma unroll
    for (int dd = 0; dd < 4; ++dd) kb[dd] = K_lds + KB * SHM_K + KSWZ(r32, (dd * 16 + hi * 8) * 2);
#pragma unroll
    for (int d0 = 0; d0 < 8; ++d0) { const char* a = kb[d0 & 3] + (d0 >> 2) * 128;
        bf16x8 b0 = *reinterpret_cast<const bf16x8*>(a);
        bf16x8 b1 = *reinterpret_cast<const bf16x8*>(a + 32 * 256);
        const bf16x8 qv = *reinterpret_cast<const bf16x8*>(qf + d0 * 1024);
        p0 = __builtin_amdgcn_mfma_f32_32x32x16_bf16(b0, qv, p0, 0, 0, 0);
        p1 = __builtin_amdgcn_mfma_f32_32x32x16_bf16(b1, qv, p1, 0, 0, 0); }
}
template <int VB>
__device__ __forceinline__ void pv_tile(f32x16* o, int vb0, bf16x8 pa0, bf16x8 pa1, bf16x8 pa2, bf16x8 pa3) {
#define TRRD(dst, off) asm volatile("ds_read_b64_tr_b16 %0, %1 offset:%2" : "=&v"(dst) : "v"(vb0), "i"(off) : "memory")
#define PV_D0(d0) do { s16x4 l0, l1, l2, l3, h0, h1, h2, h3; constexpr int b_ = VB * SHM_V + v_rd_off(d0, 0, 0);   \
        TRRD(l0, b_); TRRD(h0, b_ + 2048); TRRD(l1, b_ + 4096); TRRD(h1, b_ + 6144); TRRD(l2, b_ + 8192); TRRD(h2, b_ + 10240); TRRD(l3, b_ + 12288); TRRD(h3, b_ + 14336); \
        asm volatile("s_waitcnt lgkmcnt(0)" ::: "memory"); SBAR();   \
        o[d0] = __builtin_amdgcn_mfma_f32_32x32x16_bf16(pa0, (bf16x8){l0[0], l0[1], l0[2], l0[3], h0[0], h0[1], h0[2], h0[3]}, o[d0], 0, 0, 0);   \
        o[d0] = __builtin_amdgcn_mfma_f32_32x32x16_bf16(pa1, (bf16x8){l1[0], l1[1], l1[2], l1[3], h1[0], h1[1], h1[2], h1[3]}, o[d0], 0, 0, 0);   \
        o[d0] = __builtin_amdgcn_mfma_f32_32x32x16_bf16(pa2, (bf16x8){l2[0], l2[1], l2[2], l2[3], h2[0], h2[1], h2[2], h2[3]}, o[d0], 0, 0, 0);   \
        o[d0] = __builtin_amdgcn_mfma_f32_32x32x16_bf16(pa3, (bf16x8){l3[0], l3[1], l3[2], l3[3], h3[0], h3[1], h3[2], h3[3]}, o[d0], 0, 0, 0); } while (0)
    PV_D0(0); PV_D0(1); PV_D0(2); PV_D0(3);
#undef PV_D0
#undef TRRD
}
struct BlockRef { const bf16* Q; const bf16* K; const bf16* V; bf16* O; const float* NB; int P0; };
struct Seam { bf16x8 qr[8]; bf16x8 st_v0, st_v1, st_k0, st_k1; float sb; };
#define ROW(p, k0, rr) ((p) + (size_t)((k0) + (rr)) * LDQ + sc)
#define VMW() asm volatile("s_waitcnt vmcnt(0)" ::: "memory")
#define VMWN(n) asm volatile("s_waitcnt vmcnt(%0)" :: "i"(n) : "memory")
#define SLOAD_H(Kp, Vp, NBp, k0) do { S.st_v0 = load8(ROW(Vp, k0, sr)); S.st_v1 = load8(ROW(Vp, k0, 32 + sr));              \
                         S.st_k0 = load8(ROW(Kp, k0, sr)); S.st_k1 = load8(ROW(Kp, k0, 32 + sr)); if (tid < 64) S.sb = (NBp)[(k0) + tid]; } while (0)
#define SWRITE_HK(bf) do { *(bf16x8*)(K_lds + (bf) * SHM_K + kws) = S.st_k0; *(bf16x8*)(K_lds + (bf) * SHM_K + kws + 32 * 256) = S.st_k1; if (tid < 64) bias_l[(bf) * 64 + tid] = S.sb; } while (0)
#define SWRITE_HV(bf) do { *(bf16x8*)(V_lds + (bf) * SHM_V + vst0) = S.st_v0; *(bf16x8*)(V_lds + (bf) * SHM_V + vst1) = S.st_v1; } while (0)
#define SWRITE_H(bf) do { SWRITE_HV(bf); SWRITE_HK(bf); } while (0)
__device__ __forceinline__ void prime(const BlockRef& cur, char* lds, Seam& S) {
    const int tid = threadIdx.x, wid = __builtin_amdgcn_readfirstlane(tid >> 6), lane = tid & 63, r32 = lane & 31, hi = lane >> 5;
    const int sr = tid >> 4, sc = (tid & 15) * 8, kws = KSWZ(sr, sc * 2); char* K_lds = lds + 2 * SHM_V; float* bias_l = (float*)(lds + OFF_BIAS);
    S.sb = 0.f;
    for (int d0 = 0; d0 < 8; ++d0) S.qr[d0] = load8(cur.Q + (size_t)(wid * QBLK + r32) * LDQ + d0 * 16 + hi * 8);
    SLOAD_H(cur.K, cur.V, cur.NB, 0); VMW(); SWRITE_HK(0);
    { char* qf = lds + OFF_Q + wid * 8192 + lane * 16;
#pragma unroll
      for (int d0 = 0; d0 < 8; ++d0) *(bf16x8*)(qf + d0 * 1024) = S.qr[d0]; }
    __syncthreads();
}
__device__ __forceinline__ void block(const BlockRef& cur, const BlockRef& nxt, char* lds, Seam& S) {
    const int tid = threadIdx.x, wid = __builtin_amdgcn_readfirstlane(tid >> 6), lane = tid & 63, r32 = lane & 31, hi = lane >> 5;
    const int W = 1 << 30;
    const int NT = (cur.P0 + QB - 1) / KVBLK + 1;
    const int qlo = cur.P0 + wid * QBLK, qm = qlo + r32 - 4 * hi;
    char* V_lds = lds; char* K_lds = lds + 2 * SHM_V; float* bias_l = (float*)(lds + OFF_BIAS);
    float* ws = (float*)(lds + OFF_WS) + wid * 64; float* li_l = ws, * al_l = ws + 32;
    float m_reg = -1e30f, l_reg = 0; f32x16 o[4] = {};
    const int sr = tid >> 4, sc = (tid & 15) * 8, vst0 = v_st(sr, sc), vst1 = v_st(32 + sr, sc), kws = KSWZ(sr, sc * 2);
    const int vb0 = (int)(uintptr_t)V_lds + v_rd_base(lane);
    const bf16* Kh = cur.K; const bf16* Vh = cur.V; const float* NBh = cur.NB;
    char* qf = lds + OFF_Q + wid * 8192 + lane * 16;
#define RESC(a) do { if (__any((a) < 1.f)) { if (hi == 0) al_l[r32] = (a); asm volatile("s_waitcnt lgkmcnt(0)" ::: "memory");              \
                     for (int d_ = 0; d_ < 4; ++d_) for (int r = 0; r < 16; ++r) o[d_][r] *= al_l[crow(r, hi)]; } } while (0)
#define KBASE(t) ((t) * KVBLK)
#define MASKT(P0_, P1_, t) do { const int kb_ = KBASE(t); if (kb_ + KVBLK - 1 > qlo) mask_tile(P0_, P1_, qm - kb_, (unsigned)W); } while (0)
#define SEAM_K0() do { VMWN(8); SWRITE_HK(0); SBAR(); } while (0)
    f32x16 pA0, pA1, pB0, pB1; float mnA, mnB, alA, alB; bf16x8 pa0, pa1, pa2, pa3;
    SWRITE_HV(0); SBAR();
    if (NT > 1) { SLOAD_H(Kh, Vh, NBh, KBASE(1)); }
    SBAR(); qkt<0>(pA0, pA1, K_lds, bias_l, r32, hi, qf);
    MASKT(pA0, pA1, 0); partialSM(pA0, pA1, m_reg, mnA, alA);
    if (NT > 1) { VMW(); SWRITE_H(1); }
    __syncthreads();
#define HALF_STEP(PX0, PX1, mnX, alX, PY0, PY1, alY, t, KB, VB, SB) do {                                                      \
        SBAR(); qkt<KB>(PX0, PX1, K_lds, bias_l, r32, hi, qf);                                                 \
        finishSM(PY0, PY1, alY, l_reg, pa0, pa1, pa2, pa3); SBAR();                                                           \
        if ((t) + 1 < NT) { SLOAD_H(Kh, Vh, NBh, KBASE((t) + 1)); SBAR(); }                                                   \
        pv_tile<VB>(o, vb0, pa0, pa1, pa2, pa3); MASKT(PX0, PX1, (t)); partialSM(PX0, PX1, m_reg, mnX, alX);                  \
        __syncthreads();                                                                                                      \
        if ((t) + 1 < NT) { VMW(); SWRITE_H(SB); }                                                                            \
        RESC(alX); __syncthreads(); } while (0)
    for (int t = 1; t + 1 < NT; t += 2) {
        HALF_STEP(pB0, pB1, mnB, alB, pA0, pA1, alA, t, 1, 0, 0);
        HALF_STEP(pA0, pA1, mnA, alA, pB0, pB1, alB, t + 1, 0, 1, 1);
    }
    const bool even = (NT & 1) == 0;
    if (even) { SBAR(); qkt<1>(pB0, pB1, K_lds, bias_l, r32, hi, qf); SBAR(); }
    SLOAD_H(nxt.K, nxt.V, nxt.NB, 0); SBAR();
#pragma unroll
    for (int d0 = 0; d0 < 8; ++d0) S.qr[d0] = load8(nxt.Q + (size_t)(wid * QBLK + r32) * LDQ + d0 * 16 + hi * 8);
    SBAR();
    finishSM(pA0, pA1, alA, l_reg, pa0, pa1, pa2, pa3); SBAR();
    pv_tile<0>(o, vb0, pa0, pa1, pa2, pa3);
    if (even) { MASKT(pB0, pB1, NT - 1); partialSM(pB0, pB1, m_reg, mnB, alB); __syncthreads(); RESC(alB);
        finishSM(pB0, pB1, alB, l_reg, pa0, pa1, pa2, pa3); SBAR(); pv_tile<1>(o, vb0, pa0, pa1, pa2, pa3); }
    SBAR(); SEAM_K0();
    if (hi == 0) li_l[r32] = l_reg; asm volatile("s_waitcnt lgkmcnt(0)" ::: "memory");
    float rli[16];
#pragma unroll
    for (int r = 0; r < 16; ++r) rli[r] = __builtin_amdgcn_rcpf(li_l[crow(r, hi)]);
    bf16* Ow = cur.O + (size_t)(wid * QBLK) * LDQ;
#pragma unroll
    for (int r = 0; r < 16; ++r) { const int orow = crow(r, hi);
#pragma unroll
        for (int d0 = 0; d0 < 4; ++d0) { const float v = o[d0][r] * rli[r];
            const float vn = __shfl_xor(v, 1);
            if ((r32 & 1) == 0) *(unsigned*)(Ow + (size_t)orow * LDQ + d0 * 32 + r32) = cvtpk(v, vn); } }
#pragma unroll
    for (int d0 = 0; d0 < 8; ++d0) *(bf16x8*)(qf + d0 * 1024) = S.qr[d0];
    __syncthreads();
#undef RESC
#undef KBASE
#undef MASKT
#undef SEAM_K0
#undef HALF_STEP
}
#undef ROW
#undef VMW
#undef VMWN
#undef SLOAD_H
#undef SWRITE_HK
#undef SWRITE_HV
#undef SWRITE_H
#undef KSWZ
#undef SBAR
}
namespace cg = cooperative_groups;
constexpr int NB_ = 32, S_ = 2048, DM = 1024, T_ = NB_ * S_;
constexpr int DR = 1280, DFF = 3072, DIN = 7688, NZ = 7680;
constexpr int ZC_FL = 5632, ZC_MG = 5640;
constexpr float RMS_EPS = 1e-6f;
constexpr size_t MiB = 1u << 20;
constexpr size_t WS_MOD = 1 * MiB, WS_MODF = 2 * MiB, WS_NB = 3 * MiB, WS_LOGF = 5 * MiB;
constexpr size_t WS_WIN = 8 * MiB, WS_WUP = 23 * MiB, WS_WDN = 35 * MiB, WS_WPR = 41 * MiB, WS_WPA = 44 * MiB, WS_WOUT = 46 * MiB, WS_WA = 48 * MiB, WS_WI = 49 * MiB;
constexpr size_t WS_H = 64 * MiB;
constexpr size_t WS_XR = 192 * MiB, WS_GR = 352 * MiB, WS_Q = 512 * MiB, WS_K = 640 * MiB, WS_V = 768 * MiB;
constexpr size_t WS_GF = 192 * MiB, WS_UF = 576 * MiB, WS_END = 960 * MiB;
static_assert(pg8::E_XR == WS_XR && pg8::E_GR == WS_GR && pg8::E_Q == WS_Q && pg8::E_K == WS_K && pg8::E_V == WS_V && pg8::E_GF == WS_GF && pg8::E_UF == WS_UF, "epilogue segment map");
constexpr int LDS_BYTES = 147456, NTHR = 512, NWV = 8;
#define LAS __attribute__((address_space(3)))
typedef unsigned short bf16;
typedef float f32x4 __attribute__((ext_vector_type(4)));
typedef unsigned u32x4 __attribute__((ext_vector_type(4)));
typedef short bf16x8 __attribute__((ext_vector_type(8)));
#define LDS_WAIT() asm volatile("s_waitcnt lgkmcnt(0)" ::: "memory")

struct Args {
    const float *x, *c, *w_ada, *b_ada, *g1, *w_in, *w_rconv, *b_rconv, *w_la, *b_la, *w_li, *b_li, *lam, *b_fg, *w_pr, *w_pa, *w_out, *g2, *w_up, *w_fconv, *b_fconv, *w_dn, *w_adaf, *b_adaf, *gfin;
    float* out; unsigned char* ws; int ph_lo, ph_hi;
};

__device__ __forceinline__ float wave_sum(float v) {
#pragma unroll
    for (int o = 1; o < 64; o <<= 1) v += __shfl_xor(v, o);
    return v;
}
__device__ __forceinline__ unsigned pk2(float lo, float hi) { return pg8::cvt_pk_bf16(lo, hi); }
__device__ __forceinline__ float gelu_tanh(float x) {
    const float u = x * (1.0f + 0.044715f * x * x);
    return x * __builtin_amdgcn_rcpf(1.0f + __builtin_amdgcn_exp2f(-2.302208198f * u));
}
__device__ __forceinline__ float sigm(float x) { return __builtin_amdgcn_rcpf(1.0f + __builtin_amdgcn_exp2f(-1.4426950408889634f * x)); }

__device__ __forceinline__ void transpose_item(const float* W, int ldw, int col0, bf16* WT, int K, int row0, int nblk, LAS float* scr, int item, int lane) {
    const int kb = item / nblk, nb = item % nblk, k0 = 64 * kb, n0 = 32 * nb;
#pragma unroll 8
    for (int i = 0; i < 32; ++i) { const int kk = 2 * i + (lane >> 5); scr[kk * 33 + (lane & 31)] = W[(size_t)(k0 + kk) * ldw + col0 + n0 + (lane & 31)]; }
    LDS_WAIT(); asm volatile("" ::: "memory");
    const int c = lane & 7;
#pragma unroll
    for (int j = 0; j < 4; ++j) { const int n = (lane >> 3) + 8 * j; const LAS float* s = scr + (8 * c) * 33 + n;
        u32x4 o; o.x = pk2(s[0 * 33], s[1 * 33]); o.y = pk2(s[2 * 33], s[3 * 33]); o.z = pk2(s[4 * 33], s[5 * 33]); o.w = pk2(s[6 * 33], s[7 * 33]);
        *(u32x4*)(WT + (size_t)(row0 + n0 + n) * K + k0 + 8 * c) = o; }
    LDS_WAIT(); asm volatile("" ::: "memory");
}

__device__ __forceinline__ void mod_item(const Args& a, int item, unsigned char* lds_g) {
    float* cact = (float*)lds_g;
    const int tid = threadIdx.x, wid = tid >> 6, lane = tid & 63;
    for (int e = tid; e < NB_ * DM; e += NTHR) { const int b = e >> 10, k = e & 1023; const float v = a.c[e]; cact[k * 32 + b] = v * sigm(v); }
    __syncthreads();
    const int j0 = item * 64; const bool fin = j0 >= 6 * DM;
    const float* W = fin ? a.w_adaf : a.w_ada; const int ldw = fin ? 2 * DM : 6 * DM; const int j = (fin ? j0 - 6 * DM : j0) + lane;
    float acc0 = 0.f, acc1 = 0.f, acc2 = 0.f, acc3 = 0.f;
#pragma unroll 8
    for (int k = 0; k < DM; ++k) { const float w = W[(size_t)k * ldw + j]; const f32x4 cv = *(const f32x4*)(cact + k * 32 + wid * 4);
        acc0 += cv[0] * w; acc1 += cv[1] * w; acc2 += cv[2] * w; acc3 += cv[3] * w; }
    const float bias = (fin ? a.b_adaf : a.b_ada)[j];
    float* O = (float*)(a.ws + (fin ? WS_MODF : WS_MOD)); const int ldo = fin ? 2 * DM : 6 * DM;
    O[(size_t)(wid * 4 + 0) * ldo + j] = acc0 + bias; O[(size_t)(wid * 4 + 1) * ldo + j] = acc1 + bias;
    O[(size_t)(wid * 4 + 2) * ldo + j] = acc2 + bias; O[(size_t)(wid * 4 + 3) * ldo + j] = acc3 + bias;
    __syncthreads();
}

template <bool FL, bool F32OUT>
__device__ __forceinline__ void norm_rows(const float* X, const float* g, const float* shift, const float* scale, int mod_ld, bf16* Hout, float* Fout,
                                          const float* w_in, const float* b_fg, float* logf, int gw, int ngw, float* wfl_l) {
    const int lane = threadIdx.x & 63;
    if (FL) {
        for (int e = threadIdx.x; e < 8 * DM; e += NTHR) { const int k = e >> 3, q = e & 7; wfl_l[q * DM + k] = w_in[(size_t)k * DIN + ZC_FL + q]; }
        __syncthreads();
    }
    for (int r0 = gw * 32; r0 < T_; r0 += ngw * 32) {
        const int b = r0 >> 11;
        f32x4 gs[4], sh[4];
#pragma unroll
        for (int j = 0; j < 4; ++j) { const int k = 4 * lane + 256 * j; const f32x4 gg = *(const f32x4*)(g + k), sc = *(const f32x4*)(scale + (size_t)b * mod_ld + k);
            gs[j] = gg * (sc + 1.0f); sh[j] = *(const f32x4*)(shift + (size_t)b * mod_ld + k); }
        for (int rr = 0; rr < 32; ++rr) {
            const int row = r0 + rr;
            const f32x4* xr = (const f32x4*)(X + (size_t)row * DM) + lane;
            f32x4 v[4]; float ss = 0.f;
#pragma unroll
            for (int j = 0; j < 4; ++j) { v[j] = xr[64 * j]; ss += (v[j][0] * v[j][0] + v[j][1] * v[j][1]) + (v[j][2] * v[j][2] + v[j][3] * v[j][3]); }
            const float rstd = 1.0f / sqrtf(wave_sum(ss) * (1.0f / DM) + RMS_EPS);
#pragma unroll
            for (int j = 0; j < 4; ++j) v[j] = v[j] * rstd * gs[j] + sh[j];
            if (F32OUT) {
                f32x4* o = (f32x4*)(Fout + (size_t)row * DM) + lane;
#pragma unroll
                for (int j = 0; j < 4; ++j) o[64 * j] = v[j];
            } else {
                unsigned long long* o8 = (unsigned long long*)(Hout + (size_t)row * DM) + lane;
#pragma unroll
                for (int j = 0; j < 4; ++j) o8[64 * j] = (unsigned long long)pk2(v[j][0], v[j][1]) | ((unsigned long long)pk2(v[j][2], v[j][3]) << 32);
            }
            if (FL) {
                float fl[8];
#pragma unroll
                for (int q = 0; q < 8; ++q) fl[q] = 0.f;
#pragma unroll
                for (int q = 0; q < 8; ++q)
#pragma unroll
                    for (int j = 0; j < 4; ++j) { const f32x4 w = *(const f32x4*)(wfl_l + q * DM + 4 * lane + 256 * j); fl[q] += (v[j][0] * w[0] + v[j][1] * w[1]) + (v[j][2] * w[2] + v[j][3] * w[3]); }
                float mine = 0.f;
#pragma unroll
                for (int q = 0; q < 8; ++q) { const float s = wave_sum(fl[q]); if (lane == q) mine = s; }
                if (lane < 8) { const float z = mine + b_fg[lane]; const float lf = fminf(z, 0.f) - log1pf(__expf(-fabsf(z)));
                    logf[((size_t)b * 8 + lane) * S_ + (row & (S_ - 1))] = lf; }
            }
        }
    }
}

__device__ __forceinline__ void cumsum_item(const float* logf, float* nbias, int bh, unsigned char* lds_g) {
    float* wsum = (float*)lds_g;
    const int tid = threadIdx.x, wid = tid >> 6, lane = tid & 63;
    const f32x4 v = *(const f32x4*)(logf + (size_t)bh * S_ + 4 * tid);
    const float s1 = v[0], s2 = s1 + v[1], s3 = s2 + v[2], s4 = s3 + v[3];
    float inc = s4;
#pragma unroll
    for (int o = 1; o < 64; o <<= 1) { const float t = __shfl_up(inc, o); if (lane >= o) inc += t; }
    if (lane == 63) wsum[wid] = inc;
    __syncthreads();
    float base = inc - s4;
    for (int w = 0; w < wid; ++w) base += wsum[w];
    const float k = -1.0f / att::SCALE;
    f32x4 o; o[0] = (base + s1) * k; o[1] = (base + s2) * k; o[2] = (base + s3) * k; o[3] = (base + s4) * k;
    *(f32x4*)(nbias + (size_t)bh * S_ + 4 * tid) = o;
    __syncthreads();
}

constexpr int RL_WL = 0, RL_XC = 34816, RL_HS = 69632, RL_WT = 104448, RL_CY = 108544, RL_STR = 272;
__device__ __forceinline__ void rnn_item(const Args& a, int item, unsigned char* lds_g) {
    const int tid = threadIdx.x, wid = __builtin_amdgcn_readfirstlane(tid >> 6), lane = tid & 63, fr = lane & 15, fq = lane >> 4;
    const int b = item / 20, rem = item % 20, n = rem >> 1, c2 = rem & 1;
    unsigned char* WL = lds_g + RL_WL; unsigned char* XC = lds_g + RL_XC; float* HS = (float*)(lds_g + RL_HS); float* WT = (float*)(lds_g + RL_WT); float* CY = (float*)(lds_g + RL_CY);
    const bf16* Wa_t = (const bf16*)(a.ws + WS_WA); const bf16* Wi_t = (const bf16*)(a.ws + WS_WI);
    bf16* XR = (bf16*)(a.ws + WS_XR); bf16* GR = (bf16*)(a.ws + WS_GR);
#pragma unroll
    for (int i = 0; i < 4; ++i) { const int piece = tid + NTHR * i, g = piece >> 10, pr = (piece >> 4) & 63, pc = piece & 15;
        const bf16* src = (g ? Wi_t : Wa_t) + ((size_t)n * 128 + c2 * 64 + pr) * 128 + pc * 8;
        *(u32x4*)(WL + (g * 64 + pr) * RL_STR + pc * 16) = *(const u32x4*)src; }
    if (tid < 64) CY[tid] = 0.f;
    float ba[4], bi[4], sp8[4];
#pragma unroll
    for (int j = 0; j < 4; ++j) { const int ch = n * 128 + c2 * 64 + 16 * j + fr; ba[j] = a.b_la[ch]; bi[j] = a.b_li[ch];
        const float l = -a.lam[ch]; sp8[j] = 8.0f * (fmaxf(l, 0.f) + log1pf(__expf(-fabsf(l)))); }
    const int cgp = tid & 15, tg = tid >> 4;
    float wcv[4][8], bcv[8];
#pragma unroll
    for (int e = 0; e < 8; ++e) { const int ch = n * 128 + 8 * cgp + e; bcv[e] = a.b_rconv[ch];
#pragma unroll
        for (int k = 0; k < 4; ++k) wcv[k][e] = a.w_rconv[k * DR + ch]; }
    const bf16* xrp = XR + (size_t)b * S_ * DR + n * 128 + 8 * cgp;
    u32x4 R[7];
#pragma unroll
    for (int i = 0; i < 7; ++i) { const int t = 4 * tg - 3 + i; R[i] = (t >= 0) ? *(const u32x4*)(xrp + (size_t)t * DR) : (u32x4){0u, 0u, 0u, 0u}; }
    for (int c = 0; c < 16; ++c) {
        const int t0 = 128 * c;
#pragma unroll
        for (int q = 0; q < 4; ++q) {
            float y[8];
#pragma unroll
            for (int e = 0; e < 8; ++e) y[e] = bcv[e];
#pragma unroll
            for (int k = 0; k < 4; ++k) { const u32x4 rv = R[q + k];
                y[0] += wcv[k][0] * pg8::bf_lo(rv.x); y[1] += wcv[k][1] * pg8::bf_hi(rv.x); y[2] += wcv[k][2] * pg8::bf_lo(rv.y); y[3] += wcv[k][3] * pg8::bf_hi(rv.y);
                y[4] += wcv[k][4] * pg8::bf_lo(rv.z); y[5] += wcv[k][5] * pg8::bf_hi(rv.z); y[6] += wcv[k][6] * pg8::bf_lo(rv.w); y[7] += wcv[k][7] * pg8::bf_hi(rv.w); }
            u32x4 o; o.x = pk2(y[0], y[1]); o.y = pk2(y[2], y[3]); o.z = pk2(y[4], y[5]); o.w = pk2(y[6], y[7]);
            *(u32x4*)(XC + (4 * tg + q) * RL_STR + cgp * 16) = o;
        }
        if (c + 1 < 16) {
#pragma unroll
            for (int i = 0; i < 7; ++i) R[i] = *(const u32x4*)(xrp + (size_t)(t0 + 128 + 4 * tg - 3 + i) * DR);
        }
        u32x4 G[2];
#pragma unroll
        for (int i = 0; i < 2; ++i) { const int piece = tid + NTHR * i, tok = piece >> 3, pc = piece & 7;
            G[i] = *(const u32x4*)(GR + ((size_t)b * S_ + t0 + tok) * DR + n * 128 + c2 * 64 + pc * 8); }
        __syncthreads();
        f32x4 acc[2][4];
#pragma unroll
        for (int g = 0; g < 2; ++g)
#pragma unroll
            for (int j = 0; j < 4; ++j) acc[g][j] = (f32x4){0.f, 0.f, 0.f, 0.f};
#pragma unroll
        for (int ks = 0; ks < 4; ++ks) {
            const bf16x8 A = *(const bf16x8*)(XC + (16 * wid + fr) * RL_STR + ks * 64 + fq * 16);
#pragma unroll
            for (int g = 0; g < 2; ++g)
#pragma unroll
                for (int j = 0; j < 4; ++j) { const bf16x8 Bf = *(const bf16x8*)(WL + (g * 64 + 16 * j + fr) * RL_STR + ks * 64 + fq * 16);
                    acc[g][j] = __builtin_amdgcn_mfma_f32_16x16x32_bf16(A, Bf, acc[g][j], 0, 0, 0); }
        }
        float hl[4][4], ac[4][4], Ap[4], Hp[4];
#pragma unroll
        for (int j = 0; j < 4; ++j) {
            float H = 0.f, A = 1.f;
#pragma unroll
            for (int r = 0; r < 4; ++r) {
                const int tok = 16 * wid + 4 * fq + r;
                const float xcv = __uint_as_float((unsigned)(*(const unsigned short*)(XC + tok * RL_STR + (c2 * 64 + 16 * j + fr) * 2)) << 16);
                const float ra = sigm(acc[0][j][r] + ba[j]), ii = sigm(acc[1][j][r] + bi[j]);
                const float la = -sp8[j] * ra, av = __expf(la), mult = sqrtf(fmaxf(1.0f - av * av, 0.f));
                const float u = mult * ii * xcv;
                H = av * H + u; A *= av; hl[j][r] = H; ac[j][r] = A;
            }
            float ap = 1.f, hp = 0.f;
#pragma unroll
            for (int q = 0; q < 3; ++q) { const float Aq = __shfl(A, fr + 16 * q), Hq = __shfl(H, fr + 16 * q); if (q < fq) { hp = Aq * hp + Hq; ap *= Aq; } }
            Ap[j] = ap; Hp[j] = hp;
            if (fq == 3) { WT[(wid * 64 + 16 * j + fr) * 2 + 0] = ap * A; WT[(wid * 64 + 16 * j + fr) * 2 + 1] = A * hp + H; }
        }
        __syncthreads();
#pragma unroll
        for (int j = 0; j < 4; ++j) {
            const int chl = 16 * j + fr;
            float Hc = CY[(c & 1) * 64 + chl];
            for (int w = 0; w < wid; ++w) Hc = WT[(w * 64 + chl) * 2] * Hc + WT[(w * 64 + chl) * 2 + 1];
            const float H0 = Ap[j] * Hc + Hp[j];
            float hv = 0.f;
#pragma unroll
            for (int r = 0; r < 4; ++r) { hv = ac[j][r] * H0 + hl[j][r]; HS[(16 * wid + 4 * fq + r) * 68 + chl] = hv; }
            if (wid == 7 && fq == 3) CY[((c + 1) & 1) * 64 + chl] = hv;
        }
        __syncthreads();
#pragma unroll
        for (int i = 0; i < 2; ++i) { const int piece = tid + NTHR * i, tok = piece >> 3, pc = piece & 7;
            const f32x4 h0 = *(const f32x4*)(HS + tok * 68 + pc * 8), h1 = *(const f32x4*)(HS + tok * 68 + pc * 8 + 4); const u32x4 gv = G[i];
            u32x4 o; o.x = pk2(gelu_tanh(pg8::bf_lo(gv.x)) * h0[0], gelu_tanh(pg8::bf_hi(gv.x)) * h0[1]); o.y = pk2(gelu_tanh(pg8::bf_lo(gv.y)) * h0[2], gelu_tanh(pg8::bf_hi(gv.y)) * h0[3]);
            o.z = pk2(gelu_tanh(pg8::bf_lo(gv.z)) * h1[0], gelu_tanh(pg8::bf_hi(gv.z)) * h1[1]); o.w = pk2(gelu_tanh(pg8::bf_lo(gv.w)) * h1[2], gelu_tanh(pg8::bf_hi(gv.w)) * h1[3]);
            *(u32x4*)(GR + ((size_t)b * S_ + t0 + tok) * DR + n * 128 + c2 * 64 + pc * 8) = o; }
    }
    __syncthreads();
}

__device__ __forceinline__ void convffn_phase(const Args& a, int gtid, int ngt) {
    const bf16* GF = (const bf16*)(a.ws + WS_GF); bf16* UF = (bf16*)(a.ws + WS_UF);
    constexpr int NCG = DFF / 8, NIT = (T_ / 8) * NCG;
    for (int it = gtid; it < NIT; it += ngt) {
        const int cgp = it % NCG, tg = it / NCG, ch = 8 * cgp, row0 = 8 * tg, t = row0 & (S_ - 1);
        float w0[8], w1[8], w2[8], bb[8];
#pragma unroll
        for (int e = 0; e < 8; e += 4) { const f32x4 t0 = *(const f32x4*)(a.w_fconv + ch + e), t1 = *(const f32x4*)(a.w_fconv + DFF + ch + e), t2 = *(const f32x4*)(a.w_fconv + 2 * DFF + ch + e), t3 = *(const f32x4*)(a.b_fconv + ch + e);
#pragma unroll
            for (int q = 0; q < 4; ++q) { w0[e + q] = t0[q]; w1[e + q] = t1[q]; w2[e + q] = t2[q]; bb[e + q] = t3[q]; } }
        const bf16* gp = GF + (size_t)row0 * DFF + ch; bf16* up = UF + (size_t)row0 * DFF + ch;
        u32x4 g[10];
#pragma unroll
        for (int i = 0; i < 10; ++i) g[i] = (t + i - 2 >= 0) ? *(const u32x4*)(gp + (ptrdiff_t)(i - 2) * DFF) : (u32x4){0u, 0u, 0u, 0u};
#pragma unroll
        for (int r = 0; r < 8; ++r) {
            const u32x4 uv = *(const u32x4*)(up + (size_t)r * DFF);
            const u32x4 ga = g[r], gb = g[r + 1], gc = g[r + 2];
            float y[8];
#define CV(e, A_, B_, C_) y[e] = gelu_tanh(bb[e] + w0[e] * (A_) + w1[e] * (B_) + w2[e] * (C_))
            CV(0, pg8::bf_lo(ga.x), pg8::bf_lo(gb.x), pg8::bf_lo(gc.x)); CV(1, pg8::bf_hi(ga.x), pg8::bf_hi(gb.x), pg8::bf_hi(gc.x));
            CV(2, pg8::bf_lo(ga.y), pg8::bf_lo(gb.y), pg8::bf_lo(gc.y)); CV(3, pg8::bf_hi(ga.y), pg8::bf_hi(gb.y), pg8::bf_hi(gc.y));
            CV(4, pg8::bf_lo(ga.z), pg8::bf_lo(gb.z), pg8::bf_lo(gc.z)); CV(5, pg8::bf_hi(ga.z), pg8::bf_hi(gb.z), pg8::bf_hi(gc.z));
            CV(6, pg8::bf_lo(ga.w), pg8::bf_lo(gb.w), pg8::bf_lo(gc.w)); CV(7, pg8::bf_hi(ga.w), pg8::bf_hi(gb.w), pg8::bf_hi(gc.w));
#undef CV
            u32x4 o; o.x = pk2(y[0] * pg8::bf_lo(uv.x), y[1] * pg8::bf_hi(uv.x)); o.y = pk2(y[2] * pg8::bf_lo(uv.y), y[3] * pg8::bf_hi(uv.y));
            o.z = pk2(y[4] * pg8::bf_lo(uv.z), y[5] * pg8::bf_hi(uv.z)); o.w = pk2(y[6] * pg8::bf_lo(uv.w), y[7] * pg8::bf_hi(uv.w));
            *(u32x4*)(up + (size_t)r * DFF) = o;
        }
    }
}

__device__ __forceinline__ att::BlockRef att_mkref(int L_, int pass_, bf16* QB_, const bf16* KB_, const bf16* VB_, const float* NBI) {
    const int bh = L_ >> 2, x = L_ & 3, qb = pass_ ? 7 - x : x, b = bh >> 3, h = bh & 7;
    att::BlockRef r; const size_t ro = ((size_t)b * S_ + (size_t)qb * 256) * DM + h * 128;
    r.Q = QB_ + ro; r.O = QB_ + ro; r.K = KB_ + (size_t)b * S_ * DM + h * 128; r.V = VB_ + (size_t)b * S_ * DM + h * 128; r.NB = NBI + (size_t)bh * S_; r.P0 = qb * 256; return r;
}
constexpr int NPH = 11;
__global__ void __launch_bounds__(NTHR, 2) fwd_mega(Args a) {
    extern __shared__ __attribute__((aligned(16))) unsigned char lds[];
    LAS unsigned char* lds3 = (LAS unsigned char*)lds;
    const int tid = threadIdx.x, lane = tid & 63, wave = __builtin_amdgcn_readfirstlane(tid >> 6);
    const int G = gridDim.x, bx = blockIdx.x;
    const int vcu = (G % 8 == 0) ? (bx % 8) * (G / 8) + bx / 8 : bx;
    const int gw = vcu * NWV + wave, ngw = G * NWV;
    unsigned char* ws = a.ws;
    bf16* Win_t = (bf16*)(ws + WS_WIN); bf16* Wup_t = (bf16*)(ws + WS_WUP); bf16* Wdn_t = (bf16*)(ws + WS_WDN); bf16* Wpr_t = (bf16*)(ws + WS_WPR);
    bf16* Wpa_t = (bf16*)(ws + WS_WPA); bf16* Wout_t = (bf16*)(ws + WS_WOUT); bf16* Wa_t = (bf16*)(ws + WS_WA); bf16* Wi_t = (bf16*)(ws + WS_WI);
    float* MOD = (float*)(ws + WS_MOD); float* MODF = (float*)(ws + WS_MODF); float* NBI = (float*)(ws + WS_NB); float* LOGF = (float*)(ws + WS_LOGF);
    bf16* HB = (bf16*)(ws + WS_H); bf16* XR = (bf16*)(ws + WS_XR); bf16* GR = (bf16*)(ws + WS_GR); bf16* QB_ = (bf16*)(ws + WS_Q); bf16* KB_ = (bf16*)(ws + WS_K); bf16* VB_ = (bf16*)(ws + WS_V);
    bf16* GF = (bf16*)(ws + WS_GF); bf16* UF = (bf16*)(ws + WS_UF); bf16* MG = (bf16*)a.out;
    const int lo = a.ph_lo, hi = a.ph_hi;
#ifndef PH_MASK
#define PH_MASK 0xFFFF
#endif
#define IN(k) (lo <= (k) && (k) < hi && ((PH_MASK >> (k)) & 1))
#define SEAM(k) do { if (IN(k) && IN((k) + 1)) { cg::this_grid().sync(); } } while (0)

    if (IN(0)) {
        if (bx < 128) mod_item(a, bx, lds);
        LAS float* scr = (LAS float*)(lds3 + wave * 16384);
        struct TD { const float* W; int ldw, col0, ncols, K; bf16* WT; int row0; };
        const TD td[7] = {
            {a.w_in, DIN, 0, ZC_FL, DM, Win_t, 0}, {a.w_in, DIN, ZC_MG, 2 * DM, DM, Win_t, ZC_FL}, {a.w_pr, DM, 0, DM, DR, Wpr_t, 0}, {a.w_pa, DM, 0, DM, DM, Wpa_t, 0},
            {a.w_out, DM, 0, DM, DM, Wout_t, 0}, {a.w_up, 2 * DFF, 0, 2 * DFF, DM, Wup_t, 0}, {a.w_dn, DM, 0, DM, DFF, Wdn_t, 0} };
        int base = 0;
#pragma unroll
        for (int m = 0; m < 7; ++m) { const int nblk = td[m].ncols / 32, nit = (td[m].K / 64) * nblk;
            int first = (gw - base) % ngw; if (first < 0) first += ngw;
            for (int it = first; it < nit; it += ngw) transpose_item(td[m].W, td[m].ldw, td[m].col0, td[m].WT, td[m].K, td[m].row0, nblk, scr, it, lane);
            base += nit; }
        for (int it = gw; it < 160; it += ngw) { const int g = it / 80, r = it % 80, n = r >> 3, sub = r & 7;
            transpose_item((g ? a.w_li : a.w_la) + (size_t)n * 16384, 128, 0, (g ? Wi_t : Wa_t) + (size_t)n * 16384, 128, 0, 4, scr, sub, lane); }
    }
    SEAM(0);
#ifndef NO_P1
    if (IN(1)) norm_rows<true, false>(a.x, a.g1, MOD + 0 * DM, MOD + 1 * DM, 6 * DM, HB, nullptr, a.w_in, a.b_fg, LOGF, gw, ngw, (float*)lds);
#endif
    SEAM(1);
    if (IN(2)) {
        for (int bh = bx; bh < NB_ * 8; bh += G) cumsum_item(LOGF, NBI, bh, lds);
        __syncthreads();
        pg8::Gemm g{HB, Win_t, T_, NZ, DM}; pg8::StaticOrder S; S.init(T_, NZ, G, bx);
        pg8::EpiB<0, 0> E{}; E.ws = ws; E.mg = MG;
        pg8::gemm_phase<pg8::EpiB<0, 0>, pg8::StaticOrder, true, true>(lds3, g, S, E);
    }
    SEAM(2);
    if (IN(3)) {
#ifndef NO_RNN
        for (int it = vcu; it < NB_ * 20; it += G) rnn_item(a, it, lds);
#endif
        __syncthreads();
        const int total = NB_ * 8 * 4;
#ifndef NO_ATT
        if (vcu < total) {
            att::Seam S;
            int L = vcu, pass = 0;
#define mkref(L_, pass_) att_mkref((L_), (pass_), QB_, KB_, VB_, NBI)
            att::BlockRef cur = mkref(L, 0);
            att::prime(cur, (char*)lds, S);
            for (;;) {
                const bool more_pass = pass == 0, more_item = L + G < total, last = !more_pass && !more_item;
                int Ln = L, passn = pass + 1;
                if (!more_pass) { passn = 0; Ln = more_item ? L + G : L; }
                const att::BlockRef nxt = last ? cur : mkref(Ln, passn);
                att::block(cur, nxt, (char*)lds, S);
                if (last) break;
                cur = nxt; pass = passn; L = Ln;
            }
        }
#endif
    }
    SEAM(3);
    if (IN(4)) {
        __syncthreads();
        { pg8::Gemm g{GR, Wpr_t, T_, DM, DR}; pg8::StaticOrder S; S.init(T_, DM, G, bx);
          pg8::EpiB<1> E{}; E.s0 = HB; E.l0 = DM; E.G = MG; E.g_ld = 2 * DM; E.gcol = 0;
          pg8::gemm_phase<pg8::EpiB<1>, pg8::StaticOrder, true, true>(lds3, g, S, E); }
        { pg8::Gemm g{QB_, Wpa_t, T_, DM, DM}; pg8::StaticOrder S; S.init(T_, DM, G, bx);
          pg8::EpiB<2> E{}; E.s0 = HB; E.l0 = DM; E.G = MG; E.g_ld = 2 * DM; E.gcol = DM;
          pg8::gemm_phase<pg8::EpiB<2>, pg8::StaticOrder, true, true>(lds3, g, S, E); }
    }
    SEAM(4);
    if (IN(5)) {
        pg8::Gemm g{HB, Wout_t, T_, DM, DM}; pg8::StaticOrder S; S.init(T_, DM, G, bx);
        pg8::EpiRes E{a.x, a.out, MOD + 2 * DM, 6 * DM, DM};
        pg8::gemm_phase<pg8::EpiRes, pg8::StaticOrder, true, true>(lds3, g, S, E);
    }
    SEAM(5);
    if (IN(6)) norm_rows<false, false>(a.out, a.g2, MOD + 3 * DM, MOD + 4 * DM, 6 * DM, HB, nullptr, nullptr, nullptr, nullptr, gw, ngw, nullptr);
    SEAM(6);
    if (IN(7)) {
        pg8::Gemm g{HB, Wup_t, T_, 2 * DFF, DM}; pg8::StaticOrder S; S.init(T_, 2 * DFF, G, bx);
        pg8::EpiB<0, 1> E{}; E.ws = ws; E.mg = MG;
        pg8::gemm_phase<pg8::EpiB<0, 1>, pg8::StaticOrder, true, true>(lds3, g, S, E);
    }
    SEAM(7);
    if (IN(8)) convffn_phase(a, vcu * NTHR + tid, G * NTHR);
    SEAM(8);
    if (IN(9)) {
        pg8::Gemm g{UF, Wdn_t, T_, DM, DFF}; pg8::StaticOrder S; S.init(T_, DM, G, bx);
        pg8::EpiRes E{a.out, a.out, MOD + 5 * DM, 6 * DM, DM};
        pg8::gemm_phase<pg8::EpiRes, pg8::StaticOrder, true, true>(lds3, g, S, E);
    }
    SEAM(9);
    if (IN(10)) norm_rows<false, true>(a.out, a.gfin, MODF + 0, MODF + DM, 2 * DM, nullptr, a.out, nullptr, nullptr, nullptr, gw, ngw, nullptr);
#undef IN
#undef SEAM
}

#ifndef MK_N_LAUNCHES
#define MK_N_LAUNCHES 1
#endif
extern "C" void kernel_launch(void* const* d_in, const int* in_sizes, int n_in, void* d_out, int out_size, void* d_ws, size_t ws_size, hipStream_t stream) {
    static int grid = 0;
    if (grid == 0) {
        if (n_in != 25 || in_sizes[0] != T_ * DM || out_size != T_ * DM || ws_size < WS_END) {
            fprintf(stderr, "kernel_launch: unexpected shapes (n_in %d, in0 %d, out %d, ws %zu); nothing launched\n", n_in, n_in > 0 ? in_sizes[0] : -1, out_size, ws_size); grid = -1; return; }
        int dev = 0, cus = 0, per_cu = 0;
        (void)hipGetDevice(&dev); (void)hipDeviceGetAttribute(&cus, hipDeviceAttributeMultiprocessorCount, dev);
        if (hipFuncSetAttribute((const void*)fwd_mega, hipFuncAttributeMaxDynamicSharedMemorySize, LDS_BYTES) != hipSuccess) { fprintf(stderr, "kernel_launch: hipFuncSetAttribute failed\n"); grid = -1; return; }
        if (hipOccupancyMaxActiveBlocksPerMultiprocessor(&per_cu, (const void*)fwd_mega, NTHR, LDS_BYTES) != hipSuccess || per_cu < 1) { fprintf(stderr, "kernel_launch: occupancy query says %d\n", per_cu); per_cu = 1; }
        (void)hipGetLastError();
        grid = cus > 0 ? cus : 256;
    }
    if (grid < 0) return;
    Args a{};
    const float** f = (const float**)&a;
    for (int i = 0; i < 25; ++i) f[i] = (const float*)d_in[i];
    a.out = (float*)d_out; a.ws = (unsigned char*)d_ws;
    if (MK_N_LAUNCHES == 1) {
        a.ph_lo = 0; a.ph_hi = NPH;
        void* args[] = {&a};
        const hipError_t e = hipLaunchCooperativeKernel((const void*)fwd_mega, dim3(grid), dim3(NTHR), args, LDS_BYTES, stream);
        if (e != hipSuccess) fprintf(stderr, "kernel_launch: cooperative launch failed: %s (grid %d)\n", hipGetErrorString(e), grid);
    } else {
        for (int p = 0; p < NPH; ++p) { a.ph_lo = p; a.ph_hi = p + 1; hipLaunchKernelGGL(fwd_mega, dim3(grid), dim3(NTHR), LDS_BYTES, stream, a); }
    }
}
```

```cpp
#include <hip/hip_runtime.h>
#include <hip/hip_bf16.h>
#include <hip/hip_cooperative_groups.h>
#include <cstdio>
#include <cstdint>
#include <cstddef>
namespace pg8 {
#define PG8_LAS __attribute__((address_space(3)))
typedef unsigned short bf16_t;
typedef short bf16x8 __attribute__((ext_vector_type(8)));
typedef float f32x4 __attribute__((ext_vector_type(4)));
typedef unsigned u32x4 __attribute__((ext_vector_type(4)));
constexpr int BM = 256, BK = 64, HALF = 128, HTB = HALF * BK * 2  , STAGE_BYTES = 8 * HTB, NXCD = 8, WGM = 8;

__host__ __device__ __forceinline__ int lds_byte(int r, int c) { const int st = (r >> 4) * 2 + (c >> 5), rr = r & 15, cc = c & 31, ob = rr * 64 + cc * 2; return st * 1024 + (ob ^ (((ob >> 9) & 1) << 5)); }
__host__ __device__ __forceinline__ void stage_rc(int b, int& R, int& C) { const int st = b / 1024, sb = b % 1024, swz = sb ^ (((sb >> 9) & 1) << 5); R = (st >> 1) * 16 + swz / 64; C = (st & 1) * 32 + (swz % 64) / 2; }
__host__ __device__ __forceinline__ int perm32(int rho) { const int n = rho >> 4, i = rho & 15; return 8 * (i >> 2) + 4 * n + (i & 3); }

struct Unit { int pm, pn; };
struct Gemm { const bf16_t* A; const bf16_t* Bt; int M, N, K; unsigned* dummy; };

struct StaticOrder {
    int nM, nN, nwg, G, c;
    __host__ __device__ void init(int M, int N, int G_, int c_) { nM = M / BM; nN = N / BM; nwg = nM * nN; G = G_; c = c_; }
    __host__ __device__ bool next(int i, Unit& u) const {
        const long L = (long)i * G + c; if (L >= nwg) return false;
        int wgid = (int)L; { const int q = nwg / NXCD, r = nwg % NXCD, xcd = wgid % NXCD, off = wgid / NXCD; wgid = (xcd < r ? xcd * (q + 1) : r * (q + 1) + (xcd - r) * q) + off; }
        const int nig = WGM * nN, gid = wgid / nig, fm = gid * WGM, gsz = (nM - fm) < WGM ? (nM - fm) : WGM;
        u.pm = fm + ((wgid % nig) % gsz); u.pn = (wgid % nig) / gsz; return true;
    }
    __device__ __forceinline__ void a_ready(const Unit&) const {}
    __device__ __forceinline__ void done(const Unit&) const {}
};

__device__ __forceinline__ unsigned cvt_pk_bf16(float lo, float hi) { unsigned r; asm volatile("v_cvt_pk_bf16_f32 %0, %1, %2" : "=v"(r) : "v"(lo), "v"(hi)); return r; }
typedef float f32x2 __attribute__((ext_vector_type(2)));
__device__ __forceinline__ float sigmoidf_(float x) { return __builtin_amdgcn_rcpf(1.0f + __builtin_amdgcn_exp2f(-1.4426950408889634f * x)); }
__device__ __forceinline__ float bf_lo(unsigned w) { return __uint_as_float(w << 16); }
__device__ __forceinline__ float bf_hi(unsigned w) { return __uint_as_float(w & 0xffff0000u); }

constexpr size_t EMiB = 1u << 20, E_XR = 192 * EMiB, E_GR = 352 * EMiB, E_Q = 512 * EMiB, E_K = 640 * EMiB, E_V = 768 * EMiB, E_GF = 192 * EMiB, E_UF = 576 * EMiB;
template <int MODE, int WHICH = 0> struct EpiB {
    static constexpr bool PERM = true, AFTER_DRAIN = false; static constexpr int NST = 16;
    bf16_t* s0; int l0;
    unsigned char* ws; bf16_t* mg;
    const bf16_t* G; int g_ld, gcol;
    __device__ __forceinline__ void operator()(const f32x4 (&acc)[2][2][4][2], const Unit& u, int wr, int wc, int fr, int fq) const {
        const int row0 = u.pm * BM + wr * 64 + fr; int colt = u.pn * BM; bf16_t* base = s0; int ldc = l0;
        if (MODE == 0) {
            const int pn = u.pn + gcol; size_t off; int tl;
            if (WHICH == 0) {
                if (pn < 5) { off = E_XR; ldc = 1280; tl = pn; } else if (pn < 10) { off = E_GR; ldc = 1280; tl = pn - 5; } else if (pn < 14) { off = E_Q; ldc = 1024; tl = pn - 10; }
                else if (pn < 18) { off = E_K; ldc = 1024; tl = pn - 14; } else if (pn < 22) { off = E_V; ldc = 1024; tl = pn - 18; } else { off = 0; ldc = 2048; tl = pn - 22; }
                base = (pn >= 22) ? mg : (bf16_t*)(ws + off);
            } else {
                if (pn < 12) { off = E_GF; tl = pn; } else { off = E_UF; tl = pn - 12; }
                ldc = 3072; base = (bf16_t*)(ws + off);
            }
            colt = tl * BM;
        }
        const int col0 = colt + wc * 32 + 8 * fq;
#pragma unroll
        for (int ai = 0; ai < 2; ++ai)
#pragma unroll
            for (int m = 0; m < 4; ++m) { const int row = row0 + ai * HALF + m * 16; bf16_t* rowp = base + (size_t)row * ldc + col0;
#pragma unroll
                for (int bj = 0; bj < 2; ++bj) { f32x4 v0 = acc[ai][bj][m][0], v1 = acc[ai][bj][m][1];
                    if (MODE >= 1) {
                        const u32x4 gw = *(const u32x4*)(G + (size_t)row * g_ld + gcol + col0 + bj * HALF);
                        v0[0] *= sigmoidf_(bf_lo(gw.x)); v0[1] *= sigmoidf_(bf_hi(gw.x)); v0[2] *= sigmoidf_(bf_lo(gw.y)); v0[3] *= sigmoidf_(bf_hi(gw.y));
                        v1[0] *= sigmoidf_(bf_lo(gw.z)); v1[1] *= sigmoidf_(bf_hi(gw.z)); v1[2] *= sigmoidf_(bf_lo(gw.w)); v1[3] *= sigmoidf_(bf_hi(gw.w));
                    }
                    if (MODE == 2) {
                        const u32x4 ow = *(const u32x4*)(rowp + bj * HALF);
                        v0[0] += bf_lo(ow.x); v0[1] += bf_hi(ow.x); v0[2] += bf_lo(ow.y); v0[3] += bf_hi(ow.y);
                        v1[0] += bf_lo(ow.z); v1[1] += bf_hi(ow.z); v1[2] += bf_lo(ow.w); v1[3] += bf_hi(ow.w);
                    }
                    u32x4 w; w.x = cvt_pk_bf16(v0[0], v0[1]); w.y = cvt_pk_bf16(v0[2], v0[3]); w.z = cvt_pk_bf16(v1[0], v1[1]); w.w = cvt_pk_bf16(v1[2], v1[3]);
                    *(u32x4*)(rowp + bj * HALF) = w; } }
    }
};
struct EpiRes {
    static constexpr bool PERM = false, AFTER_DRAIN = false; static constexpr int NST = 32;
    const float* base; float* out; const float* gate; int gate_ld; int ldc;
    __device__ __forceinline__ void operator()(const f32x4 (&acc)[2][2][4][2], const Unit& u, int wr, int wc, int fr, int fq) const {
        const int row0 = u.pm * BM + wr * 64 + fr, col0 = u.pn * BM + wc * 32 + 4 * fq;
        const float* gp = gate + (size_t)(u.pm >> 3) * gate_ld + col0;
        f32x4 gv[2][2];
#pragma unroll
        for (int bj = 0; bj < 2; ++bj)
#pragma unroll
            for (int n = 0; n < 2; ++n) gv[bj][n] = *(const f32x4*)(gp + bj * HALF + n * 16);
#pragma unroll
        for (int ai = 0; ai < 2; ++ai)
#pragma unroll
            for (int m = 0; m < 4; ++m) { const size_t off = (size_t)(row0 + ai * HALF + m * 16) * ldc + col0;
#pragma unroll
                for (int bj = 0; bj < 2; ++bj)
#pragma unroll
                    for (int n = 0; n < 2; ++n) { const f32x4 bs = *(const f32x4*)(base + off + bj * HALF + n * 16);
                        *(f32x4*)(out + off + bj * HALF + n * 16) = bs + gv[bj][n] * acc[ai][bj][m][n]; } }
    }
};
template <bool BASE_BF16> struct EpiResB {
    static constexpr bool PERM = true, AFTER_DRAIN = false; static constexpr int NST = 16;
    const void* base; bf16_t* out; const float* gate; int gate_ld; int ldc;
    __device__ __forceinline__ void operator()(f32x4 (&acc)[2][2][4][2], const Unit& u, int wr, int wc, int fr, int fq) const {
        const int row0 = u.pm * BM + wr * 64 + fr, col0 = u.pn * BM + wc * 32 + 8 * fq;
        const float* gp = gate + (size_t)(u.pm >> 3) * gate_ld + col0;
        f32x4 gv[2][2];
#pragma unroll
        for (int bj = 0; bj < 2; ++bj)
#pragma unroll
            for (int n = 0; n < 2; ++n) gv[bj][n] = *(const f32x4*)(gp + bj * HALF + 4 * n);
#pragma unroll
        for (int ai = 0; ai < 2; ++ai) {
#pragma unroll
            for (int m = 0; m < 4; ++m) { const size_t off = (size_t)(row0 + ai * HALF + m * 16) * ldc + col0;
#pragma unroll
                for (int bj = 0; bj < 2; ++bj) { f32x4 b0, b1;
                    if (BASE_BF16) { const u32x4 bw = *(const u32x4*)((const bf16_t*)base + off + bj * HALF);
                        b0 = (f32x4){bf_lo(bw.x), bf_hi(bw.x), bf_lo(bw.y), bf_hi(bw.y)}; b1 = (f32x4){bf_lo(bw.z), bf_hi(bw.z), bf_lo(bw.w), bf_hi(bw.w)}; }
                    else { b0 = *(const f32x4*)((const float*)base + off + bj * HALF); b1 = *(const f32x4*)((const float*)base + off + bj * HALF + 4); }
                    acc[ai][bj][m][0] = b0 + gv[bj][0] * acc[ai][bj][m][0]; acc[ai][bj][m][1] = b1 + gv[bj][1] * acc[ai][bj][m][1]; } }
            if (!BASE_BF16) asm volatile("" ::: "memory");
        }
        asm volatile("" ::: "memory");
#pragma unroll
        for (int ai = 0; ai < 2; ++ai)
#pragma unroll
            for (int m = 0; m < 4; ++m) { const size_t off = (size_t)(row0 + ai * HALF + m * 16) * ldc + col0;
#pragma unroll
                for (int bj = 0; bj < 2; ++bj) { const f32x4 v0 = acc[ai][bj][m][0], v1 = acc[ai][bj][m][1];
                    u32x4 w; w.x = cvt_pk_bf16(v0[0], v0[1]); w.y = cvt_pk_bf16(v0[2], v0[3]); w.z = cvt_pk_bf16(v1[0], v1[1]); w.w = cvt_pk_bf16(v1[2], v1[3]);
                    *(u32x4*)(out + off + bj * HALF) = w; } }
    }
};
#define DPP_SHR(old_, src_, n_) __uint_as_float((unsigned)__builtin_amdgcn_update_dpp((int)__float_as_uint(old_), (int)__float_as_uint(src_), 0x110 + (n_), 0xf, 0xf, false))
#define DPP_ROR(src_, n_) __uint_as_float((unsigned)__builtin_amdgcn_update_dpp(0, (int)__float_as_uint(src_), 0x120 + (n_), 0xf, 0xf, false))
__device__ __forceinline__ float gelu_tanh_e(float x) { const float u = x * (1.0f + 0.044715f * x * x); return x * __builtin_amdgcn_rcpf(1.0f + __builtin_amdgcn_exp2f(-2.302208198f * u)); }
struct EpiConv {
    static constexpr bool PERM = true, AFTER_DRAIN = false; static constexpr int NST = 8;
    bf16_t* act; const float* wconv; const float* bconv; float* pre; float* uf2; float* gl; PG8_LAS float* xch;
    __device__ __forceinline__ void operator()(const f32x4 (&acc)[2][2][4][2], const Unit& u, int wr, int wc, int fr, int fq) const {
        constexpr int CF = 3072;
        const int chl = wc * 32 + 8 * fq, ch0 = u.pn * 128 + chl;
        f32x4 w0[2], w1[2], w2[2], bb[2];
#pragma unroll
        for (int n = 0; n < 2; ++n) { w0[n] = *(const f32x4*)(wconv + ch0 + 4 * n); w1[n] = *(const f32x4*)(wconv + CF + ch0 + 4 * n); w2[n] = *(const f32x4*)(wconv + 2 * CF + ch0 + 4 * n); bb[n] = *(const f32x4*)(bconv + ch0 + 4 * n); }
        if (fr >= 14) {
#pragma unroll
            for (int ai = 0; ai < 2; ++ai)
#pragma unroll
                for (int n = 0; n < 2; ++n) *(PG8_LAS f32x4*)(xch + ((2 * ai + wr) * 2 + (fr - 14)) * 128 + chl + 4 * n) = acc[ai][0][3][n];
        }
        asm volatile("s_waitcnt lgkmcnt(0)" ::: "memory"); __builtin_amdgcn_s_barrier(); asm volatile("" ::: "memory");
        const bool seq_start = (u.pm & 7) == 0;
#pragma unroll
        for (int ai = 0; ai < 2; ++ai) {
            const int g = 2 * ai + wr;
            f32x4 prev[2];
#pragma unroll
            for (int n = 0; n < 2; ++n) prev[n] = (g > 0 && fr >= 14) ? *(const PG8_LAS f32x4*)(xch + ((g - 1) * 2 + (fr - 14)) * 128 + chl + 4 * n) : (f32x4){0.f, 0.f, 0.f, 0.f};
#pragma unroll
            for (int m = 0; m < 4; ++m) {
                const int row = u.pm * BM + ai * HALF + wr * 64 + m * 16 + fr;
                f32x4 pv[2], yv[2];
#pragma unroll
                for (int n = 0; n < 2; ++n)
#pragma unroll
                    for (int i = 0; i < 4; ++i) { const float c = acc[ai][0][m][n][i], p = prev[n][i];
                        const float g1 = DPP_SHR(DPP_ROR(p, 1), c, 1), g2 = DPP_SHR(DPP_ROR(p, 2), c, 2);
                        const float pr = bb[n][i] + w0[n][i] * g2 + w1[n][i] * g1 + w2[n][i] * c;
                        pv[n][i] = pr; yv[n][i] = gelu_tanh_e(pr) * acc[ai][1][m][n][i]; }
                u32x4 w; w.x = cvt_pk_bf16(yv[0][0], yv[0][1]); w.y = cvt_pk_bf16(yv[0][2], yv[0][3]); w.z = cvt_pk_bf16(yv[1][0], yv[1][1]); w.w = cvt_pk_bf16(yv[1][2], yv[1][3]);
                *(u32x4*)(act + (size_t)row * CF + ch0) = w;
                if (g == 0 && m == 0 && fr < 2 && !seq_start) {
                    float* pp = pre + ((size_t)(u.pm * 2 + fr)) * CF + ch0; float* up = uf2 + ((size_t)(u.pm * 2 + fr)) * CF + ch0;
                    *(f32x4*)pp = pv[0]; *(f32x4*)(pp + 4) = pv[1]; *(f32x4*)up = acc[ai][1][m][0]; *(f32x4*)(up + 4) = acc[ai][1][m][1]; }
                if (g == 3 && m == 3 && fr >= 14) { float* gp = gl + ((size_t)(u.pm * 2 + (fr - 14))) * CF + ch0; *(f32x4*)gp = acc[ai][0][m][0]; *(f32x4*)(gp + 4) = acc[ai][0][m][1]; }
#pragma unroll
                for (int n = 0; n < 2; ++n) prev[n] = acc[ai][0][m][n];
            }
        }
    }
};
template <class Epi, class Sched, bool ALIGN_EPI = false, bool SP2 = false>
__device__ __forceinline__ void gemm_phase(PG8_LAS unsigned char* lds, const Gemm g, const Sched& S, const Epi& E) {
    const int tid = threadIdx.x, wid = __builtin_amdgcn_readfirstlane(tid >> 6), lane = tid & 63, wr = wid >> 2, wc = wid & 3, fr = lane & 15, fq = lane >> 4;
    const int K = g.K, nt = K / BK;
    unsigned voffA[2], voffB[2];
#pragma unroll
    for (int i = 0; i < 2; ++i) { int R, C; stage_rc(tid * 16 + i * 8192, R, C); const int Rb = Epi::PERM ? ((R & ~31) + perm32(R & 31)) : R;
        voffA[i] = (unsigned)(R * K + C) * 2u; voffB[i] = (unsigned)(Rb * K + C) * 2u; }
    const size_t kstep = (size_t)(BK * 2);
    const size_t hstep = (size_t)HALF * K * 2;
    const size_t tstep = 2 * hstep;
    const unsigned ldsw = (unsigned)wid * 1024u;
    const int aoff = lds_byte(wr * 64 + fr, fq * 8), boff = lds_byte(wc * 32 + fr, fq * 8);
#define PG8_SA(b, h) (((b) * 2 + (h)) * HTB)
#define PG8_SB(b, h) ((4 + (b) * 2 + (h)) * HTB)
#define PG8_STAGE(bufoff, gbase, voff) do { _Pragma("unroll") for (int _i = 0; _i < 2; ++_i) \
        __builtin_amdgcn_global_load_lds((const unsigned*)((const char*)(gbase) + (voff)[_i]), (PG8_LAS unsigned*)(lds + (bufoff) + ldsw + _i * 8192), 16, 0, 0); } while (0)
#define PG8_LDA(dst, b, h) do { _Pragma("unroll") for (int m = 0; m < 4; ++m) _Pragma("unroll") for (int k = 0; k < 2; ++k) dst[m][k] = *(const PG8_LAS bf16x8*)(lds + PG8_SA(b, h) + aoff + m * 2048 + k * 1024); } while (0)
#define PG8_LDB(dst, b, h) do { _Pragma("unroll") for (int n = 0; n < 2; ++n) _Pragma("unroll") for (int k = 0; k < 2; ++k) dst[n][k] = *(const PG8_LAS bf16x8*)(lds + PG8_SB(b, h) + boff + n * 2048 + k * 1024); } while (0)
#define PG8_MMA(ai, bj, At, Bt) do { __builtin_amdgcn_s_setprio(1); _Pragma("unroll") for (int m = 0; m < 4; ++m) _Pragma("unroll") for (int n = 0; n < 2; ++n) _Pragma("unroll") for (int k = 0; k < 2; ++k) \
        acc[ai][bj][m][n] = __builtin_amdgcn_mfma_f32_16x16x32_bf16(Bt[n][k], At[m][k], acc[ai][bj][m][n], 0, 0, 0); __builtin_amdgcn_s_setprio(0); } while (0)
#define PG8_WAIT_V(n) asm volatile("s_waitcnt vmcnt(" #n ")" ::: "memory")
#define PG8_WAIT_V8R(rl) asm volatile("s_cmp_lg_u32 %0, 0\n\ts_cbranch_scc1 .Lpg8w%=\n\ts_waitcnt vmcnt(8)\n.Lpg8w%=:\n\ts_waitcnt vmcnt(%1)" :: "s"(__builtin_amdgcn_readfirstlane(rl)), "i"(8 + Epi::NST) : "memory", "scc")
#define PG8_WAIT_L(n) asm volatile("s_waitcnt lgkmcnt(" #n ")" ::: "memory")
#define PG8_BAR __builtin_amdgcn_s_barrier()
#define PG8_SCHED __builtin_amdgcn_sched_barrier(0)
    Unit cur, nxt; int ui = 0;
    if (!S.next(0, cur)) return;
    f32x4 acc[2][2][4][2];
#pragma unroll
    for (int a = 0; a < 2; ++a)
#pragma unroll
        for (int b = 0; b < 2; ++b)
#pragma unroll
            for (int m = 0; m < 4; ++m)
#pragma unroll
                for (int n = 0; n < 2; ++n) acc[a][b][m][n] = (f32x4){0.f, 0.f, 0.f, 0.f};
    bf16x8 At[4][2], B0[2][2], B1[2][2];
    const char* cA = (const char*)g.A + (size_t)cur.pm * tstep; const char* cB = (const char*)g.Bt + (size_t)cur.pn * tstep;
    S.a_ready(cur);
    if constexpr (SP2) {
        PG8_STAGE(PG8_SB(0, 0), cB, voffB); PG8_STAGE(PG8_SB(0, 1), cB + hstep, voffB); PG8_STAGE(PG8_SA(0, 0), cA, voffA); PG8_STAGE(PG8_SA(0, 1), cA + hstep, voffA);
        if (wr == 1) PG8_BAR;
        PG8_WAIT_V(2); PG8_BAR;
        PG8_STAGE(PG8_SB(1, 0), cB + kstep, voffB); PG8_STAGE(PG8_SA(1, 0), cA + kstep, voffA); PG8_STAGE(PG8_SB(1, 1), cB + hstep + kstep, voffB);
        PG8_WAIT_V(6); PG8_BAR;
    } else {
        PG8_STAGE(PG8_SB(0, 0), cB, voffB); PG8_STAGE(PG8_SA(0, 0), cA, voffA); PG8_STAGE(PG8_SB(0, 1), cB + hstep, voffB); PG8_STAGE(PG8_SA(0, 1), cA + hstep, voffA);
        if (wr == 1) PG8_BAR;
        PG8_WAIT_V(4); PG8_BAR;
        PG8_STAGE(PG8_SB(1, 0), cB + kstep, voffB); PG8_STAGE(PG8_SA(1, 0), cA + kstep, voffA); PG8_STAGE(PG8_SB(1, 1), cB + hstep + kstep, voffB);
        PG8_WAIT_V(6); PG8_BAR;
    }
    for (;;) {
        const bool has_next = S.next(ui + 1, nxt);
        const char* nA = has_next ? (const char*)g.A + (size_t)nxt.pm * tstep : cA; const char* nB = has_next ? (const char*)g.Bt + (size_t)nxt.pn * tstep : cB;
        for (int t = 0; t < nt; t += 2) {
            const bool last = (t == nt - 2);
            const int relax = (ui > 0 && t == 0) ? 1 : 0;
            const char* a1 = cA + (size_t)(t + 1) * kstep;
            const char* a2 = last ? nA : cA + (size_t)(t + 2) * kstep; const char* b2 = last ? nB : cB + (size_t)(t + 2) * kstep;
            const char* a3 = a2 + kstep; const char* b3 = b2 + kstep;
            if (last && has_next) S.a_ready(nxt);
            if constexpr (SP2) {
            PG8_LDB(B0, 0, 0); PG8_LDB(B1, 0, 1); PG8_SCHED; PG8_LDA(At, 0, 0); PG8_STAGE(PG8_SA(1, 1), a1 + hstep, voffA);
            PG8_WAIT_V8R(relax); PG8_WAIT_L(0); PG8_BAR; PG8_MMA(0, 0, At, B0); PG8_MMA(0, 1, At, B1); PG8_BAR; PG8_SCHED;
            PG8_LDA(At, 0, 1); PG8_STAGE(PG8_SB(0, 0), b2, voffB); PG8_STAGE(PG8_SB(0, 1), b2 + hstep, voffB); PG8_STAGE(PG8_SA(0, 0), a2, voffA);
            PG8_WAIT_V8R(relax); PG8_WAIT_L(0); PG8_BAR; PG8_MMA(1, 0, At, B0); PG8_MMA(1, 1, At, B1); PG8_BAR; PG8_SCHED;
            PG8_LDB(B0, 1, 0); PG8_LDB(B1, 1, 1); PG8_SCHED; PG8_LDA(At, 1, 0); PG8_STAGE(PG8_SA(0, 1), a2 + hstep, voffA);
            PG8_WAIT_V(8); PG8_WAIT_L(0); PG8_BAR; PG8_MMA(0, 0, At, B0); PG8_MMA(0, 1, At, B1); PG8_BAR; PG8_SCHED;
            PG8_LDA(At, 1, 1); PG8_STAGE(PG8_SB(1, 0), b3, voffB); PG8_STAGE(PG8_SB(1, 1), b3 + hstep, voffB); PG8_STAGE(PG8_SA(1, 0), a3, voffA);
            PG8_WAIT_V(8); PG8_WAIT_L(0); PG8_BAR; PG8_MMA(1, 0, At, B0); PG8_MMA(1, 1, At, B1); PG8_BAR; PG8_SCHED;
            } else {
            PG8_LDB(B0, 0, 0); PG8_SCHED; PG8_LDA(At, 0, 0); PG8_STAGE(PG8_SA(1, 1), a1 + hstep, voffA);
            PG8_WAIT_L(8); PG8_BAR; PG8_WAIT_L(0); PG8_MMA(0, 0, At, B0); PG8_BAR; PG8_SCHED;
            PG8_LDB(B1, 0, 1); PG8_STAGE(PG8_SB(0, 0), b2, voffB);
            PG8_BAR; PG8_WAIT_L(0); PG8_MMA(0, 1, At, B1); PG8_BAR;
            PG8_LDA(At, 0, 1); PG8_STAGE(PG8_SA(0, 0), a2, voffA);
            PG8_BAR; PG8_WAIT_L(0); PG8_MMA(1, 0, At, B0); PG8_BAR; PG8_SCHED;
            PG8_STAGE(PG8_SB(0, 1), b2 + hstep, voffB);
            PG8_WAIT_V(6); PG8_BAR; PG8_MMA(1, 1, At, B1); PG8_BAR;
            PG8_LDB(B0, 1, 0); PG8_SCHED; PG8_LDA(At, 1, 0); PG8_STAGE(PG8_SA(0, 1), a2 + hstep, voffA);
            PG8_WAIT_L(8); PG8_BAR; PG8_WAIT_L(0); PG8_MMA(0, 0, At, B0); PG8_BAR; PG8_SCHED;
            PG8_LDB(B1, 1, 1); PG8_STAGE(PG8_SB(1, 0), b3, voffB);
            PG8_BAR; PG8_WAIT_L(0); PG8_MMA(0, 1, At, B1); PG8_BAR;
            PG8_LDA(At, 1, 1); PG8_STAGE(PG8_SA(1, 0), a3, voffA);
            PG8_BAR; PG8_WAIT_L(0); PG8_MMA(1, 0, At, B0); PG8_BAR; PG8_SCHED;
            PG8_STAGE(PG8_SB(1, 1), b3 + hstep, voffB);
            PG8_WAIT_V(6); PG8_BAR; PG8_MMA(1, 1, At, B1); PG8_BAR;
            }
        }
        if constexpr (ALIGN_EPI) { if (wr == 0) PG8_BAR; }
        if constexpr (!Epi::AFTER_DRAIN) { E(acc, cur, wr, wc, fr, fq); S.done(cur); }
        if (!has_next) break;
#pragma unroll
        for (int a = 0; a < 2; ++a)
#pragma unroll
            for (int b = 0; b < 2; ++b)
#pragma unroll
                for (int m = 0; m < 4; ++m)
#pragma unroll
                    for (int n = 0; n < 2; ++n) acc[a][b][m][n] = (f32x4){0.f, 0.f, 0.f, 0.f};
        cur = nxt; cA = nA; cB = nB; ++ui;
        if constexpr (ALIGN_EPI) { if (wr == 1) PG8_BAR; }
    }
    PG8_WAIT_V(0);
    if constexpr (!ALIGN_EPI) { if (wr == 0) PG8_BAR; }
    PG8_BAR;
    if constexpr (Epi::AFTER_DRAIN) { E.fused(acc, cur, wr, wc, fr, fq, lds, wid, lane); S.done(cur); }
#undef PG8_SA
#undef PG8_SB
#undef PG8_STAGE
#undef PG8_LDA
#undef PG8_LDB
#undef PG8_MMA
#undef PG8_WAIT_V
#undef PG8_WAIT_V8R
#undef PG8_WAIT_L
#undef PG8_BAR
#undef PG8_SCHED
}
}
namespace att {
constexpr int D = 128, LDQ = 1024, NW = 8, QBLK = 32, KVBLK = 64, QB = NW * QBLK;
constexpr int SHM_V = KVBLK * D * 2, SHM_K = KVBLK * D * 2;
constexpr int OFF_V = 0, OFF_K = 3 * SHM_V, OFF_WS = OFF_K + 2 * SHM_K, OFF_BIAS = OFF_WS + NW * 64 * 4, OFF_O = OFF_BIAS + 2 * 64 * 4, LDS_BYTES = OFF_O + NW * 8192;
constexpr float SCALE = 0.08838834764831845f, THR = 8.f;
typedef unsigned short bf16;
typedef short bf16x8 __attribute__((ext_vector_type(8)));
typedef short s16x4 __attribute__((ext_vector_type(4)));
typedef float f32x16 __attribute__((ext_vector_type(16)));
typedef float f32x4 __attribute__((ext_vector_type(4)));
typedef unsigned u32x4 __attribute__((ext_vector_type(4)));
#define ALAS __attribute__((address_space(3)))
#define KSWZ(row, colB) ((row) * 256 + ((colB) ^ (((row) & 7) << 4)))
#define SBAR() __builtin_amdgcn_sched_barrier(0)
__device__ __forceinline__ int v_st(int k, int c) { const int kk = (k & ~0xC) | ((k & 4) << 1) | ((k & 8) >> 1); return ((kk >> 3) * 4 + (c >> 5)) * 512 + ((kk & 7) * 32 + (c & 31)) * 2; }
__device__ __forceinline__ int v_rd_base(int lane) { return ((lane & 3) << 3) | (((lane >> 2) & 3) << 6) | (((lane >> 4) & 1) << 5) | (((lane >> 5) & 1) << 8); }
constexpr int v_rd_off(int d0, int ks, int half) { return d0 * 512 + ks * 4096 + half * 2048; }
__device__ __forceinline__ int crow(int r, int hi) { return (r & 3) + 8 * (r >> 2) + 4 * hi; }
__device__ __forceinline__ unsigned cvtpk(float lo, float hi) { unsigned r; asm volatile("v_cvt_pk_bf16_f32 %0, %1, %2" : "=v"(r) : "v"(lo), "v"(hi)); return r; }
__device__ __forceinline__ bf16x8 load8(const bf16* p) { return *reinterpret_cast<const bf16x8*>(p); }
__device__ __forceinline__ void mask_tile(f32x16& p0, f32x16& p1, int dq, unsigned W) {
    const float NEG = -__builtin_inff();
#pragma unroll
    for (int r = 0; r < 16; ++r) {
        const int c = (r & 3) + 8 * (r >> 2);
        if ((unsigned)(dq - c) >= W) p0[r] = NEG;
        if ((unsigned)(dq - c - 32) >= W) p1[r] = NEG;
    }
}
__device__ __forceinline__ void partialSM(f32x16& p0, f32x16& p1, float& m_reg, float& mn, float& alpha) {
    float pmax = p0[0]; for (int r = 1; r < 16; ++r) pmax = fmaxf(pmax, p0[r]); for (int r = 0; r < 16; ++r) pmax = fmaxf(pmax, p1[r]);
    { auto rr = __builtin_amdgcn_permlane32_swap(__float_as_uint(pmax), __float_as_uint(pmax), false, false);
      pmax = fmaxf(__uint_as_float(rr[0]), __uint_as_float(rr[1])); }
    constexpr float C2 = 1.4426950408889634f * SCALE;
    if (__builtin_expect(__all((pmax - m_reg) * SCALE <= THR), 1)) { mn = m_reg; alpha = 1.f; }
    else { mn = fmaxf(m_reg, pmax); alpha = __builtin_amdgcn_exp2f((m_reg - mn) * C2); m_reg = mn; }
    const float mnL = -mn * C2;
    for (int r = 0; r < 16; ++r) p0[r] = fmaf(p0[r], C2, mnL); for (int r = 0; r < 16; ++r) p1[r] = fmaf(p1[r], C2, mnL);
    for (int r = 0; r < 16; ++r) p0[r] = __builtin_amdgcn_exp2f(p0[r]);
}
__device__ __forceinline__ void finishSM(f32x16& p0, f32x16& p1, float alpha, float& l_reg, bf16x8& pa0, bf16x8& pa1, bf16x8& pa2, bf16x8& pa3) {
    for (int r = 0; r < 16; ++r) p1[r] = __builtin_amdgcn_exp2f(p1[r]);
    float ps = 0; for (int r = 0; r < 16; ++r) ps += p0[r]; for (int r = 0; r < 16; ++r) ps += p1[r];
    { auto rr = __builtin_amdgcn_permlane32_swap(__float_as_uint(ps), __float_as_uint(ps), false, false);
      ps = __uint_as_float(rr[0]) + __uint_as_float(rr[1]); }
    l_reg = l_reg * alpha + ps;
#define PK4(P, B_, OUT) do { unsigned a0 = cvtpk(P[B_+0], P[B_+1]), a1 = cvtpk(P[B_+2], P[B_+3]);                          \
        unsigned b0 = cvtpk(P[B_+4], P[B_+5]), b1 = cvtpk(P[B_+6], P[B_+7]);                                             \
        auto r0 = __builtin_amdgcn_permlane32_swap(a0, b0, false, false); auto r1 = __builtin_amdgcn_permlane32_swap(a1, b1, false, false); \
        u32x4 w = {r0[0], r1[0], r0[1], r1[1]}; OUT = *reinterpret_cast<bf16x8*>(&w); } while (0)
    PK4(p0, 0, pa0); PK4(p0, 8, pa1); PK4(p1, 0, pa2); PK4(p1, 8, pa3);
#undef PK4
}
template <int KB>
__device__ __forceinline__ void qkt(f32x16& p0, f32x16& p1, const ALAS char* K_lds, const ALAS float* bias_l, int r32, int hi, const bf16x8* qr) {
    const ALAS float* bl = bias_l + KB * 64 + 4 * hi;
#pragma unroll
    for (int g = 0; g < 4; ++g) { const f32x4 t0 = *(const ALAS f32x4*)(bl + 8 * g), t1 = *(const ALAS f32x4*)(bl + 32 + 8 * g);
#pragma unroll
        for (int i = 0; i < 4; ++i) { p0[4 * g + i] = t0[i]; p1[4 * g + i] = t1[i]; } }
    const ALAS char* kb[4];
#pragma unroll
    for (int dd = 0; dd < 4; ++dd) kb[dd] = K_lds + KB * SHM_K + KSWZ(r32, (dd * 16 + hi * 8) * 2);
#pragma unroll
    for (int d0 = 0; d0 < 8; ++d0) { const ALAS char* a = kb[d0 & 3] + (d0 >> 2) * 128;
        bf16x8 b0 = *(const ALAS bf16x8*)(a);
        bf16x8 b1 = *(const ALAS bf16x8*)(a + 32 * 256);
        const bf16x8 qv = qr[d0];
        p0 = __builtin_amdgcn_mfma_f32_32x32x16_bf16(b0, qv, p0, 0, 0, 0);
        p1 = __builtin_amdgcn_mfma_f32_32x32x16_bf16(b1, qv, p1, 0, 0, 0); }
}
template <int VB>
__device__ __forceinline__ void pv_tile(f32x16* o, int vb0, bf16x8 pa0, bf16x8 pa1, bf16x8 pa2, bf16x8 pa3) {
#define TRRD(dst, off) asm volatile("ds_read_b64_tr_b16 %0, %1 offset:%2" : "=&v"(dst) : "v"(vb0), "i"(off) : "memory")
#define PV_D0(d0) do { s16x4 l0, l1, l2, l3, h0, h1, h2, h3; constexpr int b_ = VB * SHM_V + v_rd_off(d0, 0, 0);   \
        TRRD(l0, b_); TRRD(h0, b_ + 2048); TRRD(l1, b_ + 4096); TRRD(h1, b_ + 6144); TRRD(l2, b_ + 8192); TRRD(h2, b_ + 10240); TRRD(l3, b_ + 12288); TRRD(h3, b_ + 14336); \
        asm volatile("s_waitcnt lgkmcnt(0)" ::: "memory"); SBAR();   \
        o[d0] = __builtin_amdgcn_mfma_f32_32x32x16_bf16(pa0, (bf16x8){l0[0], l0[1], l0[2], l0[3], h0[0], h0[1], h0[2], h0[3]}, o[d0], 0, 0, 0);   \
        o[d0] = __builtin_amdgcn_mfma_f32_32x32x16_bf16(pa1, (bf16x8){l1[0], l1[1], l1[2], l1[3], h1[0], h1[1], h1[2], h1[3]}, o[d0], 0, 0, 0);   \
        o[d0] = __builtin_amdgcn_mfma_f32_32x32x16_bf16(pa2, (bf16x8){l2[0], l2[1], l2[2], l2[3], h2[0], h2[1], h2[2], h2[3]}, o[d0], 0, 0, 0);   \
        o[d0] = __builtin_amdgcn_mfma_f32_32x32x16_bf16(pa3, (bf16x8){l3[0], l3[1], l3[2], l3[3], h3[0], h3[1], h3[2], h3[3]}, o[d0], 0, 0, 0); } while (0)
    PV_D0(0); PV_D0(1); PV_D0(2); PV_D0(3);
#undef PV_D0
#undef TRRD
}
struct BlockRef { const bf16* Q; const bf16* K; const bf16* V; bf16* O; const float* NB; int P0; };
struct Seam { bf16x8 qr[8]; int vslot; };
#define WAITB() do { asm volatile("s_waitcnt vmcnt(0) lgkmcnt(0)" ::: "memory"); __builtin_amdgcn_s_barrier(); asm volatile("" ::: "memory"); } while (0)
#define DMA_TILE(Kp, Vp, NBp, k0, kb, vs) do { const bf16* kp_ = (Kp) + (unsigned)((k0) * LDQ); const bf16* vp_ = (Vp) + (unsigned)((k0) * LDQ);                                   \
        __builtin_amdgcn_global_load_lds((const unsigned*)(kp_ + koff0), (ALAS unsigned*)(K_lds + (kb) * SHM_K + wid * 2048), 16, 0, 0);                                         \
        __builtin_amdgcn_global_load_lds((const unsigned*)(kp_ + koff1), (ALAS unsigned*)(K_lds + (kb) * SHM_K + wid * 2048 + 1024), 16, 0, 0);                                  \
        __builtin_amdgcn_global_load_lds((const unsigned*)(vp_ + voff0), (ALAS unsigned*)(V_lds + (vs) * SHM_V + wid * 2048), 16, 0, 0);                                         \
        __builtin_amdgcn_global_load_lds((const unsigned*)(vp_ + voff1), (ALAS unsigned*)(V_lds + (vs) * SHM_V + wid * 2048 + 1024), 16, 0, 0);                                  \
        if (wid == 0) __builtin_amdgcn_global_load_lds((const unsigned*)((NBp) + (unsigned)((k0) + lane)), (ALAS unsigned*)(bias_l + (kb) * 64), 4, 0, 0); } while (0)
#define DMA_OFFSETS() unsigned koff0, koff1, voff0, voff1;                                                                                                                       \
    { const int c0 = 2 * wid, c1 = c0 + 1, r0_ = 4 * c0 + (lane >> 4), r1_ = 4 * c1 + (lane >> 4), p_ = lane & 15;                                                              \
      koff0 = (unsigned)(r0_ * LDQ + ((p_ ^ (r0_ & 7)) * 8)); koff1 = (unsigned)(r1_ * LDQ + ((p_ ^ (r1_ & 7)) * 8));                                                          \
      const int U0 = 64 * c0 + lane, U1 = 64 * c1 + lane;                                                                                                                        \
      { const int s_ = U0 >> 5, kk = (s_ >> 2) * 8 + ((U0 & 31) >> 2), cc = (s_ & 3) * 32 + (U0 & 3) * 8, k_ = (kk & ~0xC) | ((kk & 4) << 1) | ((kk & 8) >> 1); voff0 = (unsigned)(k_ * LDQ + cc); } \
      { const int s_ = U1 >> 5, kk = (s_ >> 2) * 8 + ((U1 & 31) >> 2), cc = (s_ & 3) * 32 + (U1 & 3) * 8, k_ = (kk & ~0xC) | ((kk & 4) << 1) | ((kk & 8) >> 1); voff1 = (unsigned)(k_ * LDQ + cc); } }
__device__ __forceinline__ void prime(const BlockRef& cur, char* lds_g, Seam& S) {
    ALAS char* lds = (ALAS char*)lds_g;
    const int tid = threadIdx.x, wid = __builtin_amdgcn_readfirstlane(tid >> 6), lane = tid & 63, r32 = lane & 31, hi = lane >> 5;
    ALAS char* V_lds = lds + OFF_V; ALAS char* K_lds = lds + OFF_K; ALAS float* bias_l = (ALAS float*)(lds + OFF_BIAS);
    DMA_OFFSETS();
    for (int d0 = 0; d0 < 8; ++d0) S.qr[d0] = load8(cur.Q + (unsigned)((wid * QBLK + r32) * LDQ + d0 * 16 + hi * 8));
    S.vslot = 0;
    DMA_TILE(cur.K, cur.V, cur.NB, 0, 0, 0);
    WAITB();
}
__device__ __forceinline__ void block(const BlockRef& cur, const BlockRef& nxt, char* lds_g, Seam& S) {
    ALAS char* lds = (ALAS char*)lds_g;
    const int tid = threadIdx.x, wid = __builtin_amdgcn_readfirstlane(tid >> 6), lane = tid & 63, r32 = lane & 31, hi = lane >> 5;
    const int W = 1 << 30;
    const int NT = cur.P0 / KVBLK + 4;
    const int qlo = cur.P0 + wid * QBLK, qm = qlo + r32 - 4 * hi;
    ALAS char* V_lds = lds + OFF_V; ALAS char* K_lds = lds + OFF_K; ALAS float* bias_l = (ALAS float*)(lds + OFF_BIAS);
    ALAS float* ws = (ALAS float*)(lds + OFF_WS) + wid * 64; ALAS float* li_l = ws; ALAS float* al_l = ws + 32;
    float m_reg = -1e30f, l_reg = 0; f32x16 o[4] = {};
    DMA_OFFSETS();
    const int vb0 = (int)(unsigned)(__SIZE_TYPE__)V_lds + v_rd_base(lane);
    const bf16* Kh = cur.K; const bf16* Vh = cur.V; const float* NBh = cur.NB;
    int sA = S.vslot, sB = (sA == 2) ? 0 : sA + 1, sC = (sB == 2) ? 0 : sB + 1;
#define ROT() do { sA = sB; sB = sC; sC = (sC == 2) ? 0 : sC + 1; } while (0)
#define RESC(a) do { if (__any((a) < 1.f)) { if (hi == 0) al_l[r32] = (a); asm volatile("s_waitcnt lgkmcnt(0)" ::: "memory");              \
                     for (int d_ = 0; d_ < 4; ++d_) for (int r = 0; r < 16; ++r) o[d_][r] *= al_l[crow(r, hi)]; } } while (0)
#define KBASE(t) ((t) * KVBLK)
#define MASKT(P0_, P1_, t) do { const int kb_ = KBASE(t); if (kb_ + KVBLK - 1 > qlo) mask_tile(P0_, P1_, qm - kb_, (unsigned)W); } while (0)
    f32x16 pA0, pA1, pB0, pB1; float mnA, mnB, alA, alB; bf16x8 pa0, pa1, pa2, pa3;
    DMA_TILE(Kh, Vh, NBh, KBASE(1), 1, sB);
    SBAR(); qkt<0>(pA0, pA1, K_lds, bias_l, r32, hi, S.qr);
    MASKT(pA0, pA1, 0); partialSM(pA0, pA1, m_reg, mnA, alA);
    WAITB();
#define HALF_STEP(PX0, PX1, mnX, alX, PY0, PY1, alY, t, KB) do {                                                              \
        SBAR(); qkt<KB>(PX0, PX1, K_lds, bias_l, r32, hi, S.qr);                                                              \
        finishSM(PY0, PY1, alY, l_reg, pa0, pa1, pa2, pa3); SBAR();                                                           \
        if ((t) + 1 < NT) { DMA_TILE(Kh, Vh, NBh, KBASE((t) + 1), 1 - KB, sC); SBAR(); }                                      \
        pv_tile<0>(o, vb0 + sA * SHM_V, pa0, pa1, pa2, pa3); MASKT(PX0, PX1, (t)); partialSM(PX0, PX1, m_reg, mnX, alX);      \
        RESC(alX); WAITB(); ROT(); } while (0)
    for (int t = 1; t + 1 < NT; t += 2) {
        HALF_STEP(pB0, pB1, mnB, alB, pA0, pA1, alA, t, 1);
        HALF_STEP(pA0, pA1, mnA, alA, pB0, pB1, alB, t + 1, 0);
    }
    SBAR(); qkt<1>(pB0, pB1, K_lds, bias_l, r32, hi, S.qr); SBAR();
    { unsigned zo = 0; asm volatile("" : "+s"(zo));
      const bf16* nK = nxt.K + zo; const bf16* nV = nxt.V + zo; const float* nN = nxt.NB + zo; const bf16* nQ = nxt.Q + zo;
      DMA_TILE(nK, nV, nN, 0, 0, sC); SBAR();
#pragma unroll
      for (int d0 = 0; d0 < 8; ++d0) S.qr[d0] = load8(nQ + (unsigned)((wid * QBLK + r32) * LDQ + d0 * 16 + hi * 8)); }
    SBAR();
    finishSM(pA0, pA1, alA, l_reg, pa0, pa1, pa2, pa3); SBAR();
    pv_tile<0>(o, vb0 + sA * SHM_V, pa0, pa1, pa2, pa3);
    MASKT(pB0, pB1, NT - 1); partialSM(pB0, pB1, m_reg, mnB, alB); RESC(alB);
    finishSM(pB0, pB1, alB, l_reg, pa0, pa1, pa2, pa3); SBAR(); pv_tile<0>(o, vb0 + sB * SHM_V, pa0, pa1, pa2, pa3);
    S.vslot = sC;
    if (hi == 0) li_l[r32] = l_reg; asm volatile("s_waitcnt lgkmcnt(0)" ::: "memory");
    float rli[16];
#pragma unroll
    for (int r = 0; r < 16; ++r) rli[r] = __builtin_amdgcn_rcpf(li_l[crow(r, hi)]);
    unsigned zo2 = 0; asm volatile("" : "+s"(zo2)); bf16* ob = cur.O + zo2;
    bf16* Ow = ob + (unsigned)((wid * QBLK) * LDQ);
    { int ln = lane; asm volatile("" : "+v"(ln));
      ALAS bf16* stg = (ALAS bf16*)(lds + OFF_O + wid * 8192);
#pragma unroll
      for (int r = 0; r < 16; ++r) { const int orow = crow(r, hi);
#pragma unroll
          for (int d0 = 0; d0 < 4; ++d0) { const float v = o[d0][r] * rli[r]; stg[orow * 128 + d0 * 32 + r32] = (bf16)(cvtpk(v, v) & 0xffffu); } }
      asm volatile("s_waitcnt lgkmcnt(0)" ::: "memory");
#pragma unroll
      for (int i = 0; i < 8; ++i) { const int row = i * 4 + (ln >> 4), ch = ln & 15;
          const u32x4 w = *(const ALAS u32x4*)(stg + row * 128 + ch * 8);
          *(u32x4*)(Ow + (unsigned)(row * LDQ + ch * 8)) = w; if (i & 1) asm volatile("" ::: "memory"); }
      asm volatile("s_waitcnt lgkmcnt(0)" ::: "memory"); }
    asm volatile("s_waitcnt vmcnt(8) lgkmcnt(0)" ::: "memory"); __builtin_amdgcn_s_barrier(); asm volatile("" ::: "memory");
#undef RESC
#undef KBASE
#undef MASKT
#undef HALF_STEP
#undef ROT
}
#undef DMA_TILE
#undef DMA_OFFSETS
#undef WAITB
#undef KSWZ
#undef SBAR
}
namespace cg = cooperative_groups;
constexpr int NB_ = 32, S_ = 2048, DM = 1024, T_ = NB_ * S_;
constexpr int DR = 1280, DFF = 3072, DIN = 7688, NZ = 7680;
constexpr int ZC_FL = 5632, ZC_MG = 5640;
constexpr float RMS_EPS = 1e-6f;
constexpr size_t MiB = 1u << 20;
constexpr size_t WS_MOD = 1 * MiB, WS_MODF = 2 * MiB, WS_NB = 3 * MiB, WS_LOGF = 5 * MiB;
constexpr size_t WS_WIN = 8 * MiB, WS_WUP = 23 * MiB, WS_WDN = 35 * MiB, WS_WPR = 41 * MiB, WS_WPA = 44 * MiB, WS_WOUT = 46 * MiB, WS_WA = 48 * MiB, WS_WI = 49 * MiB;
constexpr size_t WS_H = 64 * MiB;
constexpr size_t WS_XR = 192 * MiB, WS_GR = 352 * MiB, WS_Q = 512 * MiB, WS_K = 640 * MiB, WS_V = 768 * MiB;
constexpr size_t WS_GF = 192 * MiB, WS_UF = 576 * MiB, WS_END = 960 * MiB;
constexpr size_t WS_PRE = 192 * MiB, WS_UF2 = 200 * MiB, WS_GL = 208 * MiB;
static_assert(pg8::E_XR == WS_XR && pg8::E_GR == WS_GR && pg8::E_Q == WS_Q && pg8::E_K == WS_K && pg8::E_V == WS_V && pg8::E_GF == WS_GF && pg8::E_UF == WS_UF, "epilogue segment map");
constexpr int LDS_BYTES = 163840, NTHR = 512, NWV = 8;
#define LAS __attribute__((address_space(3)))
typedef unsigned short bf16;
typedef float f32x4 __attribute__((ext_vector_type(4)));
typedef unsigned u32x4 __attribute__((ext_vector_type(4)));
typedef short bf16x8 __attribute__((ext_vector_type(8)));
#define LDS_WAIT() asm volatile("s_waitcnt lgkmcnt(0)" ::: "memory")
constexpr int MISC_OFF = LDS_BYTES - 64;
constexpr size_t CTL_ZERO_BYTES = 65536;
#define XB_TMO      128
#define XB_XCNT(j)  (256  + 64 * (j))
#define XB_XSUB(j)  (1280 + 64 * (j))
#define XB_XGEN(j)  (2304 + 64 * (j))
#define XB_TOP      3328
#define XB_TOPGEN   3392
#define XCD_BAR_WORDS 3456
#define XB_SPIN_CAP (1u << 18)

__device__ __forceinline__ unsigned xb_ld(unsigned* p)              { return __hip_atomic_load(p, __ATOMIC_RELAXED, __HIP_MEMORY_SCOPE_AGENT); }
__device__ __forceinline__ unsigned xb_add(unsigned* p, unsigned v) { return __hip_atomic_fetch_add(p, v, __ATOMIC_RELAXED, __HIP_MEMORY_SCOPE_AGENT); }
__device__ __forceinline__ unsigned xb_xcc_id() { return (unsigned)__builtin_amdgcn_s_getreg((3 << 11) | 20) & 0xFu; }
#define XB_SPIN(cond, bar) do { unsigned _sp = 0; while (cond) { __builtin_amdgcn_s_sleep(1); \
    if ((++_sp & 255u) == 0u) { if (xb_ld(&(bar)[XB_TMO])) break; if (_sp > XB_SPIN_CAP) { atomicAdd(&(bar)[XB_TMO], 1u); break; } } } } while (0)

struct XcdBarrier {
    unsigned* bar; unsigned x;
    volatile LAS unsigned* st;
};

__device__ __forceinline__ XcdBarrier xcd_barrier_post(unsigned* bar, volatile LAS unsigned* st) {
    XcdBarrier b; b.bar = bar; b.x = xb_xcc_id(); b.st = st;
    if (threadIdx.x == 0) (void)xb_add(&bar[XB_XCNT(b.x)], 1u);
    return b;
}
__device__ __forceinline__ void xcd_barrier_complete(unsigned* bar, unsigned x, unsigned& nloc, unsigned& nx) {
    const unsigned G = gridDim.x * gridDim.y * gridDim.z;
    unsigned sum, cnt, mine, sp = 0u;
    for (;;) {
        sum = 0u; cnt = 0u; mine = 0u;
#pragma unroll
        for (unsigned j = 0; j < 16; ++j) { const unsigned c = xb_ld(&bar[XB_XCNT(j)]); sum += c; cnt += (c > 0u) ? 1u : 0u; mine = (j == x) ? c : mine; }
        if (sum == G) break;
        __builtin_amdgcn_s_sleep(1);
        if ((++sp & 255u) == 0u) { if (xb_ld(&bar[XB_TMO])) break; if (sp > XB_SPIN_CAP) { atomicAdd(&bar[XB_TMO], 1u); break; } }
    }
    nloc = mine > 0u ? mine : 1u; nx = cnt > 0u ? cnt : 1u;
}

__device__ __forceinline__ void xcd_barrier(const XcdBarrier& b) {
    asm volatile("s_waitcnt vmcnt(0)" ::: "memory");
    __syncthreads();
    if (threadIdx.x == 0) {
        unsigned* bar = b.bar;
        __builtin_amdgcn_s_waitcnt(0);
        unsigned nloc = b.st[0], nx = b.st[1];
        if (nloc == 0u) { xcd_barrier_complete(bar, b.x, nloc, nx); b.st[0] = nloc; b.st[1] = nx; }
        const unsigned old = xb_add(&bar[XB_XSUB(b.x)], 1u);
        const unsigned gen = old / nloc;
        if (old + 1u == (gen + 1u) * nloc) {
            __builtin_amdgcn_fence(__ATOMIC_RELEASE, "agent");
            asm volatile("s_waitcnt vmcnt(0)" ::: "memory");
            const unsigned og = xb_add(&bar[XB_TOP], 1u);
            const unsigned tg = og / nx;
            if (og + 1u == (tg + 1u) * nx) xb_add(&bar[XB_TOPGEN], 1u);
            else XB_SPIN(xb_ld(&bar[XB_TOPGEN]) == tg, bar);
            __builtin_amdgcn_fence(__ATOMIC_ACQUIRE, "agent");
            xb_add(&bar[XB_XGEN(b.x)], 1u);
            asm volatile("s_waitcnt vmcnt(0)" ::: "memory");
        } else {
            XB_SPIN(xb_ld(&bar[XB_XGEN(b.x)]) == gen, bar);
            __builtin_amdgcn_fence(__ATOMIC_ACQUIRE, "agent");
            asm volatile("s_waitcnt vmcnt(0)" ::: "memory");
        }
    }
    __syncthreads();
}

struct Args {
    const float *x, *c, *w_ada, *b_ada, *g1, *w_in, *w_rconv, *b_rconv, *w_la, *b_la, *w_li, *b_li, *lam, *b_fg, *w_pr, *w_pa, *w_out, *g2, *w_up, *w_fconv, *b_fconv, *w_dn, *w_adaf, *b_adaf, *gfin;
    float* out; unsigned char* ws; int ph_lo, ph_hi, use_cg, pad;
};

__device__ __forceinline__ float wave_sum(float v) {
#pragma unroll
    for (int o = 1; o < 64; o <<= 1) v += __shfl_xor(v, o);
    return v;
}
__device__ __forceinline__ unsigned pk2(float lo, float hi) { return pg8::cvt_pk_bf16(lo, hi); }
__device__ __forceinline__ float gelu_tanh(float x) {
    const float u = x * (1.0f + 0.044715f * x * x);
    return x * __builtin_amdgcn_rcpf(1.0f + __builtin_amdgcn_exp2f(-2.302208198f * u));
}
__device__ __forceinline__ float sigm(float x) { return __builtin_amdgcn_rcpf(1.0f + __builtin_amdgcn_exp2f(-1.4426950408889634f * x)); }

__device__ __forceinline__ void transpose_item(const float* W, int ldw, int col0, bf16* WT, int K, int row0, int nblk, LAS float* scr, int item, int lane) {
    const int kb = item / nblk, nb = item % nblk, k0 = 64 * kb, n0 = 32 * nb;
#pragma unroll 8
    for (int i = 0; i < 32; ++i) { const int kk = 2 * i + (lane >> 5); scr[kk * 33 + (lane & 31)] = W[(size_t)(k0 + kk) * ldw + col0 + n0 + (lane & 31)]; }
    LDS_WAIT(); asm volatile("" ::: "memory");
    const int c = lane & 7;
#pragma unroll
    for (int j = 0; j < 4; ++j) { const int n = (lane >> 3) + 8 * j; const LAS float* s = scr + (8 * c) * 33 + n;
        u32x4 o; o.x = pk2(s[0 * 33], s[1 * 33]); o.y = pk2(s[2 * 33], s[3 * 33]); o.z = pk2(s[4 * 33], s[5 * 33]); o.w = pk2(s[6 * 33], s[7 * 33]);
        *(u32x4*)(WT + (size_t)(row0 + n0 + n) * K + k0 + 8 * c) = o; }
    LDS_WAIT(); asm volatile("" ::: "memory");
}

__device__ __forceinline__ void mod_item(const Args& a, int item, unsigned char* lds_g) {
    float* cact = (float*)lds_g;
    const int tid = threadIdx.x, col = tid & 31, ks = tid >> 5;
    for (int e = tid; e < NB_ * DM; e += NTHR) { const int b = e >> 10, k = e & 1023; const float v = a.c[e]; cact[k * 32 + b] = v * sigm(v); }
    __syncthreads();
    const int j0 = item * 32; const bool fin = j0 >= 6 * DM;
    const float* W = fin ? a.w_adaf : a.w_ada; const int ldw = fin ? 2 * DM : 6 * DM; const int jb = fin ? j0 - 6 * DM : j0;
    float acc[32];
#pragma unroll
    for (int b = 0; b < 32; ++b) acc[b] = 0.f;
    const float* wp = W + (size_t)(ks * 64) * ldw + jb + col;
#pragma unroll 1
    for (int kk = 0; kk < 64; kk += 16) {
        float wv[16];
#pragma unroll
        for (int u = 0; u < 16; ++u) wv[u] = wp[(size_t)(kk + u) * ldw];
#pragma unroll
        for (int u = 0; u < 16; ++u) { const float* cr = cact + (ks * 64 + kk + u) * 32;
#pragma unroll
            for (int q = 0; q < 8; ++q) { const f32x4 cv = *(const f32x4*)(cr + 4 * q);
                acc[4 * q + 0] += cv[0] * wv[u]; acc[4 * q + 1] += cv[1] * wv[u]; acc[4 * q + 2] += cv[2] * wv[u]; acc[4 * q + 3] += cv[3] * wv[u]; } }
    }
    __syncthreads();
    float* red = (float*)lds_g;
#pragma unroll
    for (int b = 0; b < 32; ++b) red[(ks * 32 + b) * 32 + col] = acc[b];
    __syncthreads();
    float* O = (float*)(a.ws + (fin ? WS_MODF : WS_MOD)); const int ldo = fin ? 2 * DM : 6 * DM;
    const float* bias = fin ? a.b_adaf : a.b_ada;
#pragma unroll
    for (int i = 0; i < 2; ++i) { const int o = tid + NTHR * i, b = o >> 5, c = o & 31; float s = bias[jb + c];
#pragma unroll
        for (int k2 = 0; k2 < 16; ++k2) s += red[(k2 * 32 + b) * 32 + c];
        O[(size_t)b * ldo + jb + c] = s; }
    __syncthreads();
}

template <bool FL, bool F32OUT, bool BF16IN = false>
__device__ __forceinline__ void norm_rows(const float* X, const float* g, const float* shift, const float* scale, int mod_ld, bf16* Hout, float* Fout,
                                          const float* w_in, const float* b_fg, float* logf, int gw, int ngw, float* wfl_l) {
    const int lane = threadIdx.x & 63;
    if (FL) {
        for (int e = threadIdx.x; e < 8 * DM; e += NTHR) { const int k = e >> 3, q = e & 7; wfl_l[q * DM + k] = w_in[(size_t)k * DIN + ZC_FL + q]; }
        __syncthreads();
    }
    for (int r0 = gw * 32; r0 < T_; r0 += ngw * 32) {
        const int b = r0 >> 11;
        f32x4 gs[4], sh[4];
#pragma unroll
        for (int j = 0; j < 4; ++j) { const int k = 4 * lane + 256 * j; const f32x4 gg = *(const f32x4*)(g + k), sc = *(const f32x4*)(scale + (size_t)b * mod_ld + k);
            gs[j] = gg * (sc + 1.0f); sh[j] = *(const f32x4*)(shift + (size_t)b * mod_ld + k); }
        f32x4 nf[4]; unsigned long long nb[4];
#define NR_LOAD(rw) do { if (BF16IN) { const unsigned long long* xb = (const unsigned long long*)((const bf16*)X + (size_t)(rw) * DM) + lane; _Pragma("unroll") for (int j = 0; j < 4; ++j) nb[j] = xb[64 * j]; } \
                         else { const f32x4* xr = (const f32x4*)(X + (size_t)(rw) * DM) + lane; _Pragma("unroll") for (int j = 0; j < 4; ++j) nf[j] = xr[64 * j]; } } while (0)
        NR_LOAD(r0);
        for (int rr = 0; rr < 32; ++rr) {
            const int row = r0 + rr;
            f32x4 v[4]; float ss = 0.f;
#pragma unroll
            for (int j = 0; j < 4; ++j) { if (BF16IN) { const unsigned lo = (unsigned)nb[j], hi = (unsigned)(nb[j] >> 32); v[j] = (f32x4){pg8::bf_lo(lo), pg8::bf_hi(lo), pg8::bf_lo(hi), pg8::bf_hi(hi)}; } else v[j] = nf[j]; }
            if (rr + 1 < 32) NR_LOAD(row + 1);
#pragma unroll
            for (int j = 0; j < 4; ++j) { ss += (v[j][0] * v[j][0] + v[j][1] * v[j][1]) + (v[j][2] * v[j][2] + v[j][3] * v[j][3]); }
            const float rstd = 1.0f / sqrtf(wave_sum(ss) * (1.0f / DM) + RMS_EPS);
#pragma unroll
            for (int j = 0; j < 4; ++j) v[j] = v[j] * rstd * gs[j] + sh[j];
            if (F32OUT) {
                f32x4* o = (f32x4*)(Fout + (size_t)row * DM) + lane;
#pragma unroll
                for (int j = 0; j < 4; ++j) o[64 * j] = v[j];
            } else {
                unsigned long long* o8 = (unsigned long long*)(Hout + (size_t)row * DM) + lane;
#pragma unroll
                for (int j = 0; j < 4; ++j) o8[64 * j] = (unsigned long long)pk2(v[j][0], v[j][1]) | ((unsigned long long)pk2(v[j][2], v[j][3]) << 32);
            }
            if (FL) {
                float fl[8];
#pragma unroll
                for (int q = 0; q < 8; ++q) fl[q] = 0.f;
#pragma unroll
                for (int q = 0; q < 8; ++q)
#pragma unroll
                    for (int j = 0; j < 4; ++j) { const f32x4 w = *(const f32x4*)(wfl_l + q * DM + 4 * lane + 256 * j); fl[q] += (v[j][0] * w[0] + v[j][1] * w[1]) + (v[j][2] * w[2] + v[j][3] * w[3]); }
                float mine = 0.f;
#pragma unroll
                for (int q = 0; q < 8; ++q) { const float s = wave_sum(fl[q]); if (lane == q) mine = s; }
                if (lane < 8) { const float z = mine + b_fg[lane]; const float lf = fminf(z, 0.f) - log1pf(__expf(-fabsf(z)));
                    logf[((size_t)b * 8 + lane) * S_ + (row & (S_ - 1))] = lf; }
            }
        }
    }
}

#undef NR_LOAD
__device__ __forceinline__ void cumsum_item(const float* logf, float* nbias, int bh, unsigned char* lds_g) {
    float* wsum = (float*)lds_g;
    const int tid = threadIdx.x, wid = tid >> 6, lane = tid & 63;
    const f32x4 v = *(const f32x4*)(logf + (size_t)bh * S_ + 4 * tid);
    const float s1 = v[0], s2 = s1 + v[1], s3 = s2 + v[2], s4 = s3 + v[3];
    float inc = s4;
#pragma unroll
    for (int o = 1; o < 64; o <<= 1) { const float t = __shfl_up(inc, o); if (lane >= o) inc += t; }
    if (lane == 63) wsum[wid] = inc;
    __syncthreads();
    float base = inc - s4;
    for (int w = 0; w < wid; ++w) base += wsum[w];
    const float k = -1.0f / att::SCALE;
    f32x4 o; o[0] = (base + s1) * k; o[1] = (base + s2) * k; o[2] = (base + s3) * k; o[3] = (base + s4) * k;
    *(f32x4*)(nbias + (size_t)bh * S_ + 4 * tid) = o;
    __syncthreads();
}

constexpr int RL_WL = 0, RL_XC = 34816, RL_HS = 69632, RL_WT = 104448, RL_CY = 108544, RL_STR = 272;
template <int NJ>
__device__ __forceinline__ void rnn_item(const Args& a, int item, int cq, unsigned char* lds_g) {
    const int tid = threadIdx.x, wid = __builtin_amdgcn_readfirstlane(tid >> 6), lane = tid & 63, fr = lane & 15, fq = lane >> 4;
    const int b = item / 20, rem = item % 20, n = rem >> 1, c2 = rem & 1, coff = c2 * 64 + cq * 32;
    unsigned char* WL = lds_g + RL_WL; unsigned char* XC = lds_g + RL_XC; float* HS = (float*)(lds_g + RL_HS); float* WT = (float*)(lds_g + RL_WT); float* CY = (float*)(lds_g + RL_CY);
    const bf16* Wa_t = (const bf16*)(a.ws + WS_WA); const bf16* Wi_t = (const bf16*)(a.ws + WS_WI);
    bf16* XR = (bf16*)(a.ws + WS_XR); bf16* GR = (bf16*)(a.ws + WS_GR);
#pragma unroll
    for (int i = 0; i < NJ; ++i) { const int piece = tid + NTHR * i, g = piece / (256 * NJ), pr = (piece >> 4) % (16 * NJ), pc = piece & 15;
        const bf16* src = (g ? Wi_t : Wa_t) + ((size_t)n * 128 + coff + pr) * 128 + pc * 8;
        *(u32x4*)(WL + (g * 16 * NJ + pr) * RL_STR + pc * 16) = *(const u32x4*)src; }
    if (tid < 64) CY[tid] = 0.f;
    constexpr float L2E = 1.4426950408889634f;
    float ba[NJ], bi[NJ], sp8[NJ];
#pragma unroll
    for (int j = 0; j < NJ; ++j) { const int ch = n * 128 + coff + 16 * j + fr; ba[j] = -L2E * a.b_la[ch]; bi[j] = -L2E * a.b_li[ch];
        const float l = -a.lam[ch]; sp8[j] = 8.0f * L2E * (fmaxf(l, 0.f) + log1pf(__expf(-fabsf(l)))); }
    const int cgp = tid & 15, tg = tid >> 4;
    float wcv[4][8], bcv[8];
#pragma unroll
    for (int e = 0; e < 8; ++e) { const int ch = n * 128 + 8 * cgp + e; bcv[e] = a.b_rconv[ch];
#pragma unroll
        for (int k = 0; k < 4; ++k) wcv[k][e] = a.w_rconv[k * DR + ch]; }
    const bf16* xrp = XR + (size_t)b * S_ * DR + n * 128 + 8 * cgp;
    bf16* grp = GR + (size_t)b * S_ * DR + n * 128 + coff;
    u32x4 R[7];
#pragma unroll
    for (int i = 0; i < 7; ++i) { const int t = 4 * tg - 3 + i; R[i] = (t >= 0) ? *(const u32x4*)(xrp + (unsigned)(t * DR)) : (u32x4){0u, 0u, 0u, 0u}; }
    for (int c = 0; c < 16; ++c) {
        const int t0 = 128 * c;
#pragma unroll
        for (int q = 0; q < 4; ++q) {
            typedef float f32x2 __attribute__((ext_vector_type(2)));
            f32x2 y2[4];
#pragma unroll
            for (int p = 0; p < 4; ++p) y2[p] = (f32x2){bcv[2 * p], bcv[2 * p + 1]};
#pragma unroll
            for (int k = 0; k < 4; ++k) { const u32x4 rv = R[q + k];
                const f32x2 x0 = {pg8::bf_lo(rv.x), pg8::bf_hi(rv.x)}, x1 = {pg8::bf_lo(rv.y), pg8::bf_hi(rv.y)}, x2 = {pg8::bf_lo(rv.z), pg8::bf_hi(rv.z)}, x3 = {pg8::bf_lo(rv.w), pg8::bf_hi(rv.w)};
                y2[0] = __builtin_elementwise_fma(x0, (f32x2){wcv[k][0], wcv[k][1]}, y2[0]); y2[1] = __builtin_elementwise_fma(x1, (f32x2){wcv[k][2], wcv[k][3]}, y2[1]);
                y2[2] = __builtin_elementwise_fma(x2, (f32x2){wcv[k][4], wcv[k][5]}, y2[2]); y2[3] = __builtin_elementwise_fma(x3, (f32x2){wcv[k][6], wcv[k][7]}, y2[3]); }
            u32x4 o; o.x = pk2(y2[0][0], y2[0][1]); o.y = pk2(y2[1][0], y2[1][1]); o.z = pk2(y2[2][0], y2[2][1]); o.w = pk2(y2[3][0], y2[3][1]);
            *(u32x4*)(XC + (4 * tg + q) * RL_STR + cgp * 16) = o;
        }
        if (c + 1 < 16) {
#pragma unroll
            for (int i = 0; i < 7; ++i) R[i] = *(const u32x4*)(xrp + (unsigned)((t0 + 128 + 4 * tg - 3 + i) * DR));
        }
        u32x4 G[NJ / 2];
#pragma unroll
        for (int i = 0; i < NJ / 2; ++i) { const int piece = tid + NTHR * i, tok = piece / (2 * NJ), pc = piece % (2 * NJ);
            G[i] = *(const u32x4*)(grp + (unsigned)((t0 + tok) * DR + pc * 8)); }
        __syncthreads();
        f32x4 acc[2][NJ];
#pragma unroll
        for (int g = 0; g < 2; ++g)
#pragma unroll
            for (int j = 0; j < NJ; ++j) acc[g][j] = (f32x4){0.f, 0.f, 0.f, 0.f};
#pragma unroll
        for (int ks = 0; ks < 4; ++ks) {
            const bf16x8 A = *(const bf16x8*)(XC + (16 * wid + fr) * RL_STR + ks * 64 + fq * 16);
#pragma unroll
            for (int g = 0; g < 2; ++g)
#pragma unroll
                for (int j = 0; j < NJ; ++j) { const bf16x8 Bf = *(const bf16x8*)(WL + (g * 16 * NJ + 16 * j + fr) * RL_STR + ks * 64 + fq * 16);
                    acc[g][j] = __builtin_amdgcn_mfma_f32_16x16x32_bf16(A, Bf, acc[g][j], 0, 0, 0); }
        }
        float hl[NJ][4], ac[NJ][4], Ap[NJ], Hp[NJ];
#pragma unroll
        for (int j = 0; j < NJ; ++j) {
            float H = 0.f, A = 1.f;
#pragma unroll
            for (int r = 0; r < 4; ++r) {
                const int tok = 16 * wid + 4 * fq + r;
                const float xcv = __uint_as_float((unsigned)(*(const unsigned short*)(XC + tok * RL_STR + (coff + 16 * j + fr) * 2)) << 16);
                const float ra = __builtin_amdgcn_rcpf(1.0f + __builtin_amdgcn_exp2f(fmaf(acc[0][j][r], -L2E, ba[j]))), ii = __builtin_amdgcn_rcpf(1.0f + __builtin_amdgcn_exp2f(fmaf(acc[1][j][r], -L2E, bi[j])));
                const float av = __builtin_amdgcn_exp2f(-sp8[j] * ra), mult = __builtin_amdgcn_sqrtf(fmaxf(fmaf(-av, av, 1.0f), 0.f));
                const float u = mult * ii * xcv;
                H = av * H + u; A *= av; hl[j][r] = H; ac[j][r] = A;
            }
            float ap = 1.f, hp = 0.f;
#pragma unroll
            for (int q = 0; q < 3; ++q) { const float Aq = __shfl(A, fr + 16 * q), Hq = __shfl(H, fr + 16 * q); if (q < fq) { hp = Aq * hp + Hq; ap *= Aq; } }
            Ap[j] = ap; Hp[j] = hp;
            if (fq == 3) { WT[(wid * 64 + 16 * j + fr) * 2 + 0] = ap * A; WT[(wid * 64 + 16 * j + fr) * 2 + 1] = A * hp + H; }
        }
        __syncthreads();
#pragma unroll
        for (int j = 0; j < NJ; ++j) {
            const int chl = 16 * j + fr;
            float Hc = CY[(c & 1) * 64 + chl];
            for (int w = 0; w < wid; ++w) Hc = WT[(w * 64 + chl) * 2] * Hc + WT[(w * 64 + chl) * 2 + 1];
            const float H0 = Ap[j] * Hc + Hp[j];
            float hv = 0.f;
#pragma unroll
            for (int r = 0; r < 4; ++r) { hv = ac[j][r] * H0 + hl[j][r]; HS[(16 * wid + 4 * fq + r) * 68 + chl] = hv; }
            if (wid == 7 && fq == 3) CY[((c + 1) & 1) * 64 + chl] = hv;
        }
        __syncthreads();
#pragma unroll
        for (int i = 0; i < NJ / 2; ++i) { const int piece = tid + NTHR * i, tok = piece / (2 * NJ), pc = piece % (2 * NJ);
            const f32x4 h0 = *(const f32x4*)(HS + tok * 68 + pc * 8), h1 = *(const f32x4*)(HS + tok * 68 + pc * 8 + 4); const u32x4 gv = G[i];
            u32x4 o; o.x = pk2(gelu_tanh(pg8::bf_lo(gv.x)) * h0[0], gelu_tanh(pg8::bf_hi(gv.x)) * h0[1]); o.y = pk2(gelu_tanh(pg8::bf_lo(gv.y)) * h0[2], gelu_tanh(pg8::bf_hi(gv.y)) * h0[3]);
            o.z = pk2(gelu_tanh(pg8::bf_lo(gv.z)) * h1[0], gelu_tanh(pg8::bf_hi(gv.z)) * h1[1]); o.w = pk2(gelu_tanh(pg8::bf_lo(gv.w)) * h1[2], gelu_tanh(pg8::bf_hi(gv.w)) * h1[3]);
            *(u32x4*)(grp + (unsigned)((t0 + tok) * DR + pc * 8)) = o; }
    }
    __syncthreads();
}

__device__ __forceinline__ void convffn_phase(const Args& a, int gtid, int ngt) {
    const bf16* GF = (const bf16*)(a.ws + WS_GF); bf16* UF = (bf16*)(a.ws + WS_UF);
    constexpr int NCG = DFF / 8, NIT = (T_ / 8) * NCG;
    for (int it = gtid; it < NIT; it += ngt) {
        const int cgp = it % NCG, tg = it / NCG, ch = 8 * cgp, row0 = 8 * tg, t = row0 & (S_ - 1);
        float w0[8], w1[8], w2[8], bb[8];
#pragma unroll
        for (int e = 0; e < 8; e += 4) { const f32x4 t0 = *(const f32x4*)(a.w_fconv + ch + e), t1 = *(const f32x4*)(a.w_fconv + DFF + ch + e), t2 = *(const f32x4*)(a.w_fconv + 2 * DFF + ch + e), t3 = *(const f32x4*)(a.b_fconv + ch + e);
#pragma unroll
            for (int q = 0; q < 4; ++q) { w0[e + q] = t0[q]; w1[e + q] = t1[q]; w2[e + q] = t2[q]; bb[e + q] = t3[q]; } }
        const bf16* gp = GF + (size_t)row0 * DFF + ch; bf16* up = UF + (size_t)row0 * DFF + ch;
        u32x4 g[10];
#pragma unroll
        for (int i = 0; i < 10; ++i) g[i] = (t + i - 2 >= 0) ? *(const u32x4*)(gp + (ptrdiff_t)(i - 2) * DFF) : (u32x4){0u, 0u, 0u, 0u};
#pragma unroll
        for (int r = 0; r < 8; ++r) {
            const u32x4 uv = *(const u32x4*)(up + (size_t)r * DFF);
            const u32x4 ga = g[r], gb = g[r + 1], gc = g[r + 2];
            float y[8];
#define CV(e, A_, B_, C_) y[e] = gelu_tanh(bb[e] + w0[e] * (A_) + w1[e] * (B_) + w2[e] * (C_))
            CV(0, pg8::bf_lo(ga.x), pg8::bf_lo(gb.x), pg8::bf_lo(gc.x)); CV(1, pg8::bf_hi(ga.x), pg8::bf_hi(gb.x), pg8::bf_hi(gc.x));
            CV(2, pg8::bf_lo(ga.y), pg8::bf_lo(gb.y), pg8::bf_lo(gc.y)); CV(3, pg8::bf_hi(ga.y), pg8::bf_hi(gb.y), pg8::bf_hi(gc.y));
            CV(4, pg8::bf_lo(ga.z), pg8::bf_lo(gb.z), pg8::bf_lo(gc.z)); CV(5, pg8::bf_hi(ga.z), pg8::bf_hi(gb.z), pg8::bf_hi(gc.z));
            CV(6, pg8::bf_lo(ga.w), pg8::bf_lo(gb.w), pg8::bf_lo(gc.w)); CV(7, pg8::bf_hi(ga.w), pg8::bf_hi(gb.w), pg8::bf_hi(gc.w));
#undef CV
            u32x4 o; o.x = pk2(y[0] * pg8::bf_lo(uv.x), y[1] * pg8::bf_hi(uv.x)); o.y = pk2(y[2] * pg8::bf_lo(uv.y), y[3] * pg8::bf_hi(uv.y));
            o.z = pk2(y[4] * pg8::bf_lo(uv.z), y[5] * pg8::bf_hi(uv.z)); o.w = pk2(y[6] * pg8::bf_lo(uv.w), y[7] * pg8::bf_hi(uv.w));
            *(u32x4*)(up + (size_t)r * DFF) = o;
        }
    }
}

__device__ __forceinline__ att::BlockRef att_mkref(int L_, int pass_, bf16* QB_, const bf16* KB_, const bf16* VB_, const float* NBI) {
    const int bh = L_ >> 2, x = L_ & 3, qb = pass_ ? 7 - x : x, b = bh >> 3, h = bh & 7;
    att::BlockRef r; const size_t ro = ((size_t)b * S_ + (size_t)qb * 256) * DM + h * 128;
    r.Q = QB_ + ro; r.O = QB_ + ro; r.K = KB_ + (size_t)b * S_ * DM + h * 128; r.V = VB_ + (size_t)b * S_ * DM + h * 128; r.NB = NBI + (size_t)bh * S_; r.P0 = qb * 256; return r;
}
#define PHASE_PTRS() size_t zo_ = 0; asm volatile("" : "+s"(zo_)); unsigned char* wsl = a.ws + zo_;     \
    bf16* Win_t = (bf16*)(wsl + WS_WIN); bf16* Wup_t = (bf16*)(wsl + WS_WUP); bf16* Wdn_t = (bf16*)(wsl + WS_WDN); bf16* Wpr_t = (bf16*)(wsl + WS_WPR); \
    bf16* Wpa_t = (bf16*)(wsl + WS_WPA); bf16* Wout_t = (bf16*)(wsl + WS_WOUT); bf16* Wa_t = (bf16*)(wsl + WS_WA); bf16* Wi_t = (bf16*)(wsl + WS_WI); \
    float* MOD = (float*)(wsl + WS_MOD); float* MODF = (float*)(wsl + WS_MODF); float* NBI = (float*)(wsl + WS_NB); float* LOGF = (float*)(wsl + WS_LOGF); \
    bf16* HB = (bf16*)(wsl + WS_H); bf16* XR = (bf16*)(wsl + WS_XR); bf16* GR = (bf16*)(wsl + WS_GR); bf16* QB_ = (bf16*)(wsl + WS_Q); bf16* KB_ = (bf16*)(wsl + WS_K); bf16* VB_ = (bf16*)(wsl + WS_V); \
    bf16* GF = (bf16*)(wsl + WS_GF); bf16* UF = (bf16*)(wsl + WS_UF); float* outl = a.out + zo_; bf16* MG = (bf16*)outl; \
    (void)Win_t; (void)Wup_t; (void)Wdn_t; (void)Wpr_t; (void)Wpa_t; (void)Wout_t; (void)Wa_t; (void)Wi_t; (void)MOD; (void)MODF; (void)NBI; (void)LOGF; (void)HB; (void)XR; (void)GR; (void)QB_; (void)KB_; (void)VB_; (void)GF; (void)UF; (void)MG
static_assert(att::LDS_BYTES <= LDS_BYTES - 64, "attention LDS map");
constexpr int NPH = 11;
__global__ void __launch_bounds__(NTHR, 2) fwd_mega(Args a) {
    extern __shared__ __attribute__((aligned(16))) unsigned char lds[];
    LAS unsigned char* lds3 = (LAS unsigned char*)lds;
    const int tid = threadIdx.x, lane = tid & 63, wave = __builtin_amdgcn_readfirstlane(tid >> 6);
    const int G = gridDim.x, bx = blockIdx.x;
    const int vcu = (G % 8 == 0) ? (bx % 8) * (G / 8) + bx / 8 : bx;
    const int gw = vcu * NWV + wave, ngw = G * NWV;
    unsigned char* ws = a.ws;
    const int lo = a.ph_lo, hi = a.ph_hi;
    const bool use_cg = a.use_cg != 0;
    if (tid < 16) ((LAS unsigned*)(lds3 + MISC_OFF))[tid] = 0u;
    __syncthreads();
    const XcdBarrier bar = xcd_barrier_post((unsigned*)ws, (volatile LAS unsigned*)(lds3 + MISC_OFF));
#ifndef PH_MASK
#define PH_MASK 0xFFFF
#endif
#define IN(k) (lo <= (k) && (k) < hi && ((PH_MASK >> (k)) & 1))
#ifndef PROBE_MASK
#define PROBE_MASK 0
#endif
    unsigned long long t_prev = 0; if (PROBE_MASK) t_prev = __builtin_amdgcn_s_memrealtime();
#define PROBE_AFTER(k) do { if (PROBE_MASK) { const unsigned long long t_now = __builtin_amdgcn_s_memrealtime(); if ((PROBE_MASK >> (k)) & 1) { const unsigned long long d_ = t_now - t_prev; \
        while (__builtin_amdgcn_s_memrealtime() - t_now < d_) __builtin_amdgcn_s_sleep(8); xcd_barrier(bar); } t_prev = __builtin_amdgcn_s_memrealtime(); } } while (0)
#define SEAM(k) do { if (IN(k) && IN((k) + 1)) { if (use_cg) cg::this_grid().sync(); else xcd_barrier(bar); PROBE_AFTER(k); } } while (0)

    if (IN(0)) { PHASE_PTRS();
        for (int it = bx; it < 256; it += G) mod_item(a, it, lds);
        LAS float* scr = (LAS float*)(lds3 + wave * 16384);
        struct TD { const float* W; int ldw, col0, ncols, K; bf16* WT; int row0; };
        const TD td[7] = {
            {a.w_in, DIN, 0, ZC_FL, DM, Win_t, 0}, {a.w_in, DIN, ZC_MG, 2 * DM, DM, Win_t, ZC_FL}, {a.w_pr, DM, 0, DM, DR, Wpr_t, 0}, {a.w_pa, DM, 0, DM, DM, Wpa_t, 0},
            {a.w_out, DM, 0, DM, DM, Wout_t, 0}, {a.w_dn, DM, 0, DM, DFF, Wdn_t, 0}, {a.w_dn, DM, 0, 0, DFF, Wdn_t, 0} };
        int base = 0;
#pragma unroll
        for (int m = 0; m < 7; ++m) { const int nblk = td[m].ncols / 32, nit = (td[m].K / 64) * nblk;
            int first = (gw - base) % ngw; if (first < 0) first += ngw;
            for (int it = first; it < nit; it += ngw) transpose_item(td[m].W, td[m].ldw, td[m].col0, td[m].WT, td[m].K, td[m].row0, nblk, scr, it, lane);
            base += nit; }
        for (int it = gw; it < 16 * 192; it += ngw) { const int nb = it % 192, c = 32 * nb, ch = c < DFF ? c : c - DFF, row = 256 * (ch >> 7) + (c < DFF ? 0 : 128) + (ch & 127);
            transpose_item(a.w_up, 2 * DFF, 0, Wup_t, DM, row - c, 192, scr, it, lane); }
        for (int it = gw; it < 160; it += ngw) { const int g = it / 80, r = it % 80, n = r >> 3, sub = r & 7;
            transpose_item((g ? a.w_li : a.w_la) + (size_t)n * 16384, 128, 0, (g ? Wi_t : Wa_t) + (size_t)n * 16384, 128, 0, 4, scr, sub, lane); }
    }
    SEAM(0);
#ifndef NO_P1
    if (IN(1)) { PHASE_PTRS(); norm_rows<true, false>(a.x, a.g1, MOD + 0 * DM, MOD + 1 * DM, 6 * DM, HB, nullptr, a.w_in, a.b_fg, LOGF, gw, ngw, (float*)lds); }
#endif
    SEAM(1);
    if (IN(2)) { PHASE_PTRS();
        for (int bh = bx; bh < NB_ * 8; bh += G) cumsum_item(LOGF, NBI, bh, lds);
        __syncthreads();
        { pg8::Gemm g{HB, Win_t, T_, 6144, DM, (unsigned*)(wsl + 128 * 1024)}; pg8::StaticOrder S; S.init(T_, 6144, G, bx);
          pg8::EpiB<0, 0> E{}; E.ws = wsl; E.mg = MG; E.gcol = 0;
          pg8::gemm_phase<pg8::EpiB<0, 0>, pg8::StaticOrder, true, true>(lds3, g, S, E); }
        { pg8::Gemm g{HB, Win_t + (size_t)6144 * DM, T_, NZ - 6144, DM, (unsigned*)(wsl + 128 * 1024)}; pg8::StaticOrder S; S.init(T_, NZ - 6144, G, bx);
          pg8::EpiB<0, 0> E{}; E.ws = wsl; E.mg = MG; E.gcol = 24;
          pg8::gemm_phase<pg8::EpiB<0, 0>, pg8::StaticOrder, true, true>(lds3, g, S, E); }
    }
    SEAM(2);
    if (IN(3)) { PHASE_PTRS();
#ifndef NO_RNN
        for (int it = vcu; it < 512; it += G) rnn_item<4>(a, it, 0, lds);
        for (int q = vcu; q < 256; q += G) rnn_item<2>(a, 512 + (q >> 1), q & 1, lds);
#endif
        __syncthreads();
        if ((PROBE_MASK >> 11) & 3) { xcd_barrier(bar); PROBE_AFTER(11); }
        const int total = NB_ * 8 * 4;
#ifndef NO_ATT
        if (vcu < total) {
            att::Seam S;
            int L = vcu, pass = 0;
#define mkref(L_, pass_) att_mkref((L_), (pass_), QB_, KB_, VB_, NBI)
            att::BlockRef cur = mkref(L, 0);
            att::prime(cur, (char*)lds, S);
            for (;;) {
                const bool more_pass = pass == 0, more_item = L + G < total, last = !more_pass && !more_item;
                int Ln = L, passn = pass + 1;
                if (!more_pass) { passn = 0; Ln = more_item ? L + G : L; }
                const att::BlockRef nxt = last ? cur : mkref(Ln, passn);
                att::block(cur, nxt, (char*)lds, S);
                if (last) break;
                cur = nxt; pass = passn; L = Ln;
            }
        }
#endif
    }
    SEAM(3);
    if (IN(4)) { PHASE_PTRS();
        __syncthreads();
        { pg8::Gemm g{GR, Wpr_t, T_, DM, DR, (unsigned*)(wsl + 128 * 1024)}; pg8::StaticOrder S; S.init(T_, DM, G, bx);
          pg8::EpiB<1> E{}; E.s0 = HB; E.l0 = DM; E.G = MG; E.g_ld = 2 * DM; E.gcol = 0;
          pg8::gemm_phase<pg8::EpiB<1>, pg8::StaticOrder, true, true>(lds3, g, S, E); }
        { pg8::Gemm g{QB_, Wpa_t, T_, DM, DM, (unsigned*)(wsl + 128 * 1024)}; pg8::StaticOrder S; S.init(T_, DM, G, bx);
          pg8::EpiB<2> E{}; E.s0 = HB; E.l0 = DM; E.G = MG; E.g_ld = 2 * DM; E.gcol = DM;
          pg8::gemm_phase<pg8::EpiB<2>, pg8::StaticOrder, true, true>(lds3, g, S, E); }
    }
    SEAM(4);
    if (IN(5)) { PHASE_PTRS();
        pg8::Gemm g{HB, Wout_t, T_, DM, DM, (unsigned*)(wsl + 128 * 1024)}; pg8::StaticOrder S; S.init(T_, DM, G, bx);
        pg8::EpiResB<false> E{a.x, GR, MOD + 2 * DM, 6 * DM, DM};
        pg8::gemm_phase<pg8::EpiResB<false>, pg8::StaticOrder, true, true>(lds3, g, S, E);
    }
    SEAM(5);
    if (IN(6)) { PHASE_PTRS(); norm_rows<false, false, true>((const float*)GR, a.g2, MOD + 3 * DM, MOD + 4 * DM, 6 * DM, HB, nullptr, nullptr, nullptr, nullptr, gw, ngw, nullptr); }
    SEAM(6);
    if (IN(7)) { PHASE_PTRS();
        pg8::Gemm g{HB, Wup_t, T_, 2 * DFF, DM, (unsigned*)(wsl + 128 * 1024)}; pg8::StaticOrder S; S.init(T_, 2 * DFF, G, bx);
        pg8::EpiConv E{UF, a.w_fconv, a.b_fconv, (float*)(wsl + WS_PRE), (float*)(wsl + WS_UF2), (float*)(wsl + WS_GL), (LAS float*)(lds3 + 131072)};
        pg8::gemm_phase<pg8::EpiConv, pg8::StaticOrder, true, true>(lds3, g, S, E);
    }
    SEAM(7);
    if (IN(8)) { PHASE_PTRS();
        const float* PRE = (const float*)(wsl + WS_PRE); const float* UF2 = (const float*)(wsl + WS_UF2); const float* GL = (const float*)(wsl + WS_GL);
        for (int e = (vcu * NTHR + tid) * 4; e < 256 * 2 * DFF; e += G * NTHR * 4) {
            const int ch = e % DFF, r = (e / DFF) & 1, pm = e / (2 * DFF);
            if ((pm & 7) == 0) continue;
            const f32x4 p = *(const f32x4*)(PRE + e), uu = *(const f32x4*)(UF2 + e);
            const f32x4 ga = *(const f32x4*)(GL + ((size_t)((pm - 1) * 2 + 0)) * DFF + ch), gb = *(const f32x4*)(GL + ((size_t)((pm - 1) * 2 + 1)) * DFF + ch);
            const f32x4 w0 = *(const f32x4*)(a.w_fconv + ch), w1 = *(const f32x4*)(a.w_fconv + DFF + ch);
            f32x4 y;
#pragma unroll
            for (int i = 0; i < 4; ++i) { const float pr = p[i] + (r == 0 ? w1[i] * gb[i] + w0[i] * ga[i] : w0[i] * gb[i]); y[i] = gelu_tanh(pr) * uu[i]; }
            *(unsigned long long*)(UF + ((size_t)pm * 256 + r) * DFF + ch) = (unsigned long long)pk2(y[0], y[1]) | ((unsigned long long)pk2(y[2], y[3]) << 32);
        }
    }
    SEAM(8);
    if (IN(9)) { PHASE_PTRS();
        pg8::Gemm g{UF, Wdn_t, T_, DM, DFF, (unsigned*)(wsl + 128 * 1024)}; pg8::StaticOrder S; S.init(T_, DM, G, bx);
        pg8::EpiResB<true> E{GR, GR, MOD + 5 * DM, 6 * DM, DM};
        pg8::gemm_phase<pg8::EpiResB<true>, pg8::StaticOrder, true, true>(lds3, g, S, E);
    }
    SEAM(9);
    if (IN(10)) { PHASE_PTRS(); norm_rows<false, true, true>((const float*)GR, a.gfin, MODF + 0, MODF + DM, 2 * DM, nullptr, outl, nullptr, nullptr, nullptr, gw, ngw, nullptr); }
#ifdef PROBE_SYNCS
#pragma unroll 1
    for (int i_ = 0; i_ < PROBE_SYNCS; ++i_) xcd_barrier(bar);
#endif
#undef IN
#undef SEAM
}

#ifndef MK_N_LAUNCHES
#define MK_N_LAUNCHES 1
#endif
extern "C" void kernel_launch(void* const* d_in, const int* in_sizes, int n_in, void* d_out, int out_size, void* d_ws, size_t ws_size, hipStream_t stream) {
    static int grid = 0;
    if (grid == 0) {
        if (n_in != 25 || in_sizes[0] != T_ * DM || out_size != T_ * DM || ws_size < WS_END) {
            fprintf(stderr, "kernel_launch: unexpected shapes (n_in %d, in0 %d, out %d, ws %zu); nothing launched\n", n_in, n_in > 0 ? in_sizes[0] : -1, out_size, ws_size); grid = -1; return; }
        int dev = 0, cus = 0, per_cu = 0;
        (void)hipGetDevice(&dev); (void)hipDeviceGetAttribute(&cus, hipDeviceAttributeMultiprocessorCount, dev);
        if (hipFuncSetAttribute((const void*)fwd_mega, hipFuncAttributeMaxDynamicSharedMemorySize, LDS_BYTES) != hipSuccess) { fprintf(stderr, "kernel_launch: hipFuncSetAttribute failed\n"); grid = -1; return; }
        if (hipOccupancyMaxActiveBlocksPerMultiprocessor(&per_cu, (const void*)fwd_mega, NTHR, LDS_BYTES) != hipSuccess || per_cu < 1) { fprintf(stderr, "kernel_launch: occupancy query says %d\n", per_cu); per_cu = 1; }
        (void)hipGetLastError();
        grid = cus > 0 ? cus : 256;
    }
    if (grid < 0) return;
    Args a{};
    const float** f = (const float**)&a;
    for (int i = 0; i < 25; ++i) f[i] = (const float*)d_in[i];
    a.out = (float*)d_out; a.ws = (unsigned char*)d_ws;
    if (hipMemsetAsync(d_ws, 0, CTL_ZERO_BYTES, stream) != hipSuccess) { fprintf(stderr, "kernel_launch: hipMemsetAsync failed\n"); return; }
    if (MK_N_LAUNCHES == 1) {
        a.ph_lo = 0; a.ph_hi = NPH;
        void* args[] = {&a};
        const hipError_t e = hipLaunchCooperativeKernel((const void*)fwd_mega, dim3(grid), dim3(NTHR), args, LDS_BYTES, stream);
        if (e != hipSuccess) fprintf(stderr, "kernel_launch: cooperative launch failed: %s (grid %d)\n", hipGetErrorString(e), grid);
    } else {
        for (int p = 0; p < NPH; ++p) { a.ph_lo = p; a.ph_hi = p + 1; hipLaunchKernelGGL(fwd_mega, dim3(grid), dim3(NTHR), LDS_BYTES, stream, a); }
    }
}
```

```cpp
#include <hip/hip_runtime.h>
#include <hip/hip_bf16.h>
#include <hip/hip_cooperative_groups.h>
#include <cstdio>
#include <cstdint>
#include <cstddef>
namespace pg8 {
#define PG8_LAS __attribute__((address_space(3)))
typedef unsigned short bf16_t;
typedef short bf16x8 __attribute__((ext_vector_type(8)));
typedef float f32x4 __attribute__((ext_vector_type(4)));
typedef unsigned u32x4 __attribute__((ext_vector_type(4)));
constexpr int BM = 256, BK = 64, HALF = 128, HTB = HALF * BK * 2  , STAGE_BYTES = 8 * HTB, NXCD = 8, WGM = 8;

__host__ __device__ __forceinline__ int lds_byte(int r, int c) { const int st = (r >> 4) * 2 + (c >> 5), rr = r & 15, cc = c & 31, ob = rr * 64 + cc * 2; return st * 1024 + (ob ^ (((ob >> 9) & 1) << 5)); }
__host__ __device__ __forceinline__ void stage_rc(int b, int& R, int& C) { const int st = b / 1024, sb = b % 1024, swz = sb ^ (((sb >> 9) & 1) << 5); R = (st >> 1) * 16 + swz / 64; C = (st & 1) * 32 + (swz % 64) / 2; }
__host__ __device__ __forceinline__ int perm32(int rho) { const int n = rho >> 4, i = rho & 15; return 8 * (i >> 2) + 4 * n + (i & 3); }

struct Unit { int pm, pn; };
struct Gemm { const bf16_t* A; const bf16_t* Bt; int M, N, K; unsigned* dummy; };

struct StaticOrder {
    int nM, nN, nwg, G, c;
    __host__ __device__ void init(int M, int N, int G_, int c_) { nM = M / BM; nN = N / BM; nwg = nM * nN; G = G_; c = c_; }
    __host__ __device__ bool next(int i, Unit& u) const {
        const long L = (long)i * G + c; if (L >= nwg) return false;
        int wgid = (int)L; { const int q = nwg / NXCD, r = nwg % NXCD, xcd = wgid % NXCD, off = wgid / NXCD; wgid = (xcd < r ? xcd * (q + 1) : r * (q + 1) + (xcd - r) * q) + off; }
        const int nig = WGM * nN, gid = wgid / nig, fm = gid * WGM, gsz = (nM - fm) < WGM ? (nM - fm) : WGM;
        u.pm = fm + ((wgid % nig) % gsz); u.pn = (wgid % nig) / gsz; return true;
    }
    __device__ __forceinline__ void a_ready(const Unit&) const {}
    __device__ __forceinline__ void done(const Unit&) const {}
};

__device__ __forceinline__ unsigned cvt_pk_bf16(float lo, float hi) { unsigned r; asm volatile("v_cvt_pk_bf16_f32 %0, %1, %2" : "=v"(r) : "v"(lo), "v"(hi)); return r; }
typedef float f32x2 __attribute__((ext_vector_type(2)));
__device__ __forceinline__ float sigmoidf_(float x) { return __builtin_amdgcn_rcpf(1.0f + __builtin_amdgcn_exp2f(-1.4426950408889634f * x)); }
__device__ __forceinline__ float bf_lo(unsigned w) { return __uint_as_float(w << 16); }
__device__ __forceinline__ float bf_hi(unsigned w) { return __uint_as_float(w & 0xffff0000u); }

constexpr size_t EMiB = 1u << 20, E_XR = 192 * EMiB, E_GR = 352 * EMiB, E_Q = 512 * EMiB, E_K = 640 * EMiB, E_V = 768 * EMiB, E_GF = 192 * EMiB, E_UF = 576 * EMiB;
template <int MODE, int WHICH = 0> struct EpiB {
    static constexpr bool PERM = true, AFTER_DRAIN = false; static constexpr int NST = 16;
    bf16_t* s0; int l0;
    unsigned char* ws; bf16_t* mg;
    const bf16_t* G; int g_ld, gcol;
    __device__ __forceinline__ void operator()(const f32x4 (&acc)[2][2][4][2], const Unit& u, int wr, int wc, int fr, int fq) const {
        const int row0 = u.pm * BM + wr * 64 + fr; int colt = u.pn * BM; bf16_t* base = s0; int ldc = l0;
        if (MODE == 0) {
            const int pn = u.pn + gcol; size_t off; int tl;
            if (WHICH == 0) {
                if (pn < 5) { off = E_XR; ldc = 1280; tl = pn; } else if (pn < 10) { off = E_GR; ldc = 1280; tl = pn - 5; } else if (pn < 14) { off = E_Q; ldc = 1024; tl = pn - 10; }
                else if (pn < 18) { off = E_K; ldc = 1024; tl = pn - 14; } else if (pn < 22) { off = E_V; ldc = 1024; tl = pn - 18; } else { off = 0; ldc = 2048; tl = pn - 22; }
                base = (pn >= 22) ? mg : (bf16_t*)(ws + off);
            } else {
                if (pn < 12) { off = E_GF; tl = pn; } else { off = E_UF; tl = pn - 12; }
                ldc = 3072; base = (bf16_t*)(ws + off);
            }
            colt = tl * BM;
        }
        const int col0 = colt + wc * 32 + 8 * fq;
#pragma unroll
        for (int ai = 0; ai < 2; ++ai) {
            u32x4 gwv[4][2];
            if (MODE >= 1) {
#pragma unroll
                for (int m = 0; m < 4; ++m)
#pragma unroll
                    for (int bj = 0; bj < 2; ++bj) gwv[m][bj] = *(const u32x4*)(G + (size_t)(row0 + ai * HALF + m * 16) * g_ld + gcol + col0 + bj * HALF);
                asm volatile("" ::: "memory");
            }
#pragma unroll
            for (int m = 0; m < 4; ++m) { const int row = row0 + ai * HALF + m * 16; bf16_t* rowp = base + (size_t)row * ldc + col0;
#pragma unroll
                for (int bj = 0; bj < 2; ++bj) { f32x4 v0 = acc[ai][bj][m][0], v1 = acc[ai][bj][m][1];
                    if (MODE >= 1) {
                        const u32x4 gw = gwv[m][bj];
                        v0[0] *= sigmoidf_(bf_lo(gw.x)); v0[1] *= sigmoidf_(bf_hi(gw.x)); v0[2] *= sigmoidf_(bf_lo(gw.y)); v0[3] *= sigmoidf_(bf_hi(gw.y));
                        v1[0] *= sigmoidf_(bf_lo(gw.z)); v1[1] *= sigmoidf_(bf_hi(gw.z)); v1[2] *= sigmoidf_(bf_lo(gw.w)); v1[3] *= sigmoidf_(bf_hi(gw.w));
                    }
                    if (MODE == 2) {
                        const u32x4 ow = *(const u32x4*)(rowp + bj * HALF);
                        v0[0] += bf_lo(ow.x); v0[1] += bf_hi(ow.x); v0[2] += bf_lo(ow.y); v0[3] += bf_hi(ow.y);
                        v1[0] += bf_lo(ow.z); v1[1] += bf_hi(ow.z); v1[2] += bf_lo(ow.w); v1[3] += bf_hi(ow.w);
                    }
                    u32x4 w; w.x = cvt_pk_bf16(v0[0], v0[1]); w.y = cvt_pk_bf16(v0[2], v0[3]); w.z = cvt_pk_bf16(v1[0], v1[1]); w.w = cvt_pk_bf16(v1[2], v1[3]);
                    *(u32x4*)(rowp + bj * HALF) = w; } }
        }
    }
};
struct EpiRes {
    static constexpr bool PERM = false, AFTER_DRAIN = false; static constexpr int NST = 32;
    const float* base; float* out; const float* gate; int gate_ld; int ldc;
    __device__ __forceinline__ void operator()(const f32x4 (&acc)[2][2][4][2], const Unit& u, int wr, int wc, int fr, int fq) const {
        const int row0 = u.pm * BM + wr * 64 + fr, col0 = u.pn * BM + wc * 32 + 4 * fq;
        const float* gp = gate + (size_t)(u.pm >> 3) * gate_ld + col0;
        f32x4 gv[2][2];
#pragma unroll
        for (int bj = 0; bj < 2; ++bj)
#pragma unroll
            for (int n = 0; n < 2; ++n) gv[bj][n] = *(const f32x4*)(gp + bj * HALF + n * 16);
#pragma unroll
        for (int ai = 0; ai < 2; ++ai)
#pragma unroll
            for (int m = 0; m < 4; ++m) { const size_t off = (size_t)(row0 + ai * HALF + m * 16) * ldc + col0;
#pragma unroll
                for (int bj = 0; bj < 2; ++bj)
#pragma unroll
                    for (int n = 0; n < 2; ++n) { const f32x4 bs = *(const f32x4*)(base + off + bj * HALF + n * 16);
                        *(f32x4*)(out + off + bj * HALF + n * 16) = bs + gv[bj][n] * acc[ai][bj][m][n]; } }
    }
};
template <bool BASE_BF16> struct EpiResB {
    static constexpr bool PERM = true, AFTER_DRAIN = false; static constexpr int NST = 16;
    const void* base; bf16_t* out; const float* gate; int gate_ld; int ldc;
    __device__ __forceinline__ void operator()(f32x4 (&acc)[2][2][4][2], const Unit& u, int wr, int wc, int fr, int fq) const {
        const int row0 = u.pm * BM + wr * 64 + fr, col0 = u.pn * BM + wc * 32 + 8 * fq;
        const float* gp = gate + (size_t)(u.pm >> 3) * gate_ld + col0;
        f32x4 gv[2][2];
#pragma unroll
        for (int bj = 0; bj < 2; ++bj)
#pragma unroll
            for (int n = 0; n < 2; ++n) gv[bj][n] = *(const f32x4*)(gp + bj * HALF + 4 * n);
#pragma unroll
        for (int ai = 0; ai < 2; ++ai) {
#pragma unroll
            for (int m = 0; m < 4; ++m) { const size_t off = (size_t)(row0 + ai * HALF + m * 16) * ldc + col0;
#pragma unroll
                for (int bj = 0; bj < 2; ++bj) { f32x4 b0, b1;
                    if (BASE_BF16) { const u32x4 bw = *(const u32x4*)((const bf16_t*)base + off + bj * HALF);
                        b0 = (f32x4){bf_lo(bw.x), bf_hi(bw.x), bf_lo(bw.y), bf_hi(bw.y)}; b1 = (f32x4){bf_lo(bw.z), bf_hi(bw.z), bf_lo(bw.w), bf_hi(bw.w)}; }
                    else { b0 = *(const f32x4*)((const float*)base + off + bj * HALF); b1 = *(const f32x4*)((const float*)base + off + bj * HALF + 4); }
                    acc[ai][bj][m][0] = b0 + gv[bj][0] * acc[ai][bj][m][0]; acc[ai][bj][m][1] = b1 + gv[bj][1] * acc[ai][bj][m][1]; } }
            if (!BASE_BF16) asm volatile("" ::: "memory");
        }
        asm volatile("" ::: "memory");
#pragma unroll
        for (int ai = 0; ai < 2; ++ai)
#pragma unroll
            for (int m = 0; m < 4; ++m) { const size_t off = (size_t)(row0 + ai * HALF + m * 16) * ldc + col0;
#pragma unroll
                for (int bj = 0; bj < 2; ++bj) { const f32x4 v0 = acc[ai][bj][m][0], v1 = acc[ai][bj][m][1];
                    u32x4 w; w.x = cvt_pk_bf16(v0[0], v0[1]); w.y = cvt_pk_bf16(v0[2], v0[3]); w.z = cvt_pk_bf16(v1[0], v1[1]); w.w = cvt_pk_bf16(v1[2], v1[3]);
                    *(u32x4*)(out + off + bj * HALF) = w; } }
    }
};
#define DPP_SHR(old_, src_, n_) __uint_as_float((unsigned)__builtin_amdgcn_update_dpp((int)__float_as_uint(old_), (int)__float_as_uint(src_), 0x110 + (n_), 0xf, 0xf, false))
#define DPP_ROR(src_, n_) __uint_as_float((unsigned)__builtin_amdgcn_update_dpp(0, (int)__float_as_uint(src_), 0x120 + (n_), 0xf, 0xf, false))
__device__ __forceinline__ float gelu_tanh_e(float x) { const float u = x * (1.0f + 0.044715f * x * x); return x * __builtin_amdgcn_rcpf(1.0f + __builtin_amdgcn_exp2f(-2.302208198f * u)); }
struct EpiConv {
    static constexpr bool PERM = true, AFTER_DRAIN = false; static constexpr int NST = 8;
    bf16_t* act; const float* wconv; const float* bconv; float* pre; float* uf2; float* gl; PG8_LAS float* xch;
    __device__ __forceinline__ void operator()(const f32x4 (&acc)[2][2][4][2], const Unit& u, int wr, int wc, int fr, int fq) const {
        constexpr int CF = 3072;
        const int chl = wc * 32 + 8 * fq, ch0 = u.pn * 128 + chl;
        f32x4 w0[2], w1[2], w2[2], bb[2];
#pragma unroll
        for (int n = 0; n < 2; ++n) { w0[n] = *(const f32x4*)(wconv + ch0 + 4 * n); w1[n] = *(const f32x4*)(wconv + CF + ch0 + 4 * n); w2[n] = *(const f32x4*)(wconv + 2 * CF + ch0 + 4 * n); bb[n] = *(const f32x4*)(bconv + ch0 + 4 * n); }
        if (fr >= 14) {
#pragma unroll
            for (int ai = 0; ai < 2; ++ai)
#pragma unroll
                for (int n = 0; n < 2; ++n) *(PG8_LAS f32x4*)(xch + ((2 * ai + wr) * 2 + (fr - 14)) * 128 + chl + 4 * n) = acc[ai][0][3][n];
        }
        asm volatile("s_waitcnt lgkmcnt(0)" ::: "memory"); __builtin_amdgcn_s_barrier(); asm volatile("" ::: "memory");
        const bool seq_start = (u.pm & 7) == 0;
#pragma unroll
        for (int ai = 0; ai < 2; ++ai) {
            const int g = 2 * ai + wr;
            f32x4 prev[2];
#pragma unroll
            for (int n = 0; n < 2; ++n) prev[n] = (g > 0 && fr >= 14) ? *(const PG8_LAS f32x4*)(xch + ((g - 1) * 2 + (fr - 14)) * 128 + chl + 4 * n) : (f32x4){0.f, 0.f, 0.f, 0.f};
#pragma unroll
            for (int m = 0; m < 4; ++m) {
                const int row = u.pm * BM + ai * HALF + wr * 64 + m * 16 + fr;
                f32x4 pv[2], yv[2];
#pragma unroll
                for (int n = 0; n < 2; ++n)
#pragma unroll
                    for (int i = 0; i < 4; ++i) { const float c = acc[ai][0][m][n][i], p = prev[n][i];
                        const float g1 = DPP_SHR(DPP_ROR(p, 1), c, 1), g2 = DPP_SHR(DPP_ROR(p, 2), c, 2);
                        const float pr = bb[n][i] + w0[n][i] * g2 + w1[n][i] * g1 + w2[n][i] * c;
                        pv[n][i] = pr; yv[n][i] = gelu_tanh_e(pr) * acc[ai][1][m][n][i]; }
                u32x4 w; w.x = cvt_pk_bf16(yv[0][0], yv[0][1]); w.y = cvt_pk_bf16(yv[0][2], yv[0][3]); w.z = cvt_pk_bf16(yv[1][0], yv[1][1]); w.w = cvt_pk_bf16(yv[1][2], yv[1][3]);
                *(u32x4*)(act + (size_t)row * CF + ch0) = w;
                if (g == 0 && m == 0 && fr < 2 && !seq_start) {
                    float* pp = pre + ((size_t)(u.pm * 2 + fr)) * CF + ch0; float* up = uf2 + ((size_t)(u.pm * 2 + fr)) * CF + ch0;
                    *(f32x4*)pp = pv[0]; *(f32x4*)(pp + 4) = pv[1]; *(f32x4*)up = acc[ai][1][m][0]; *(f32x4*)(up + 4) = acc[ai][1][m][1]; }
                if (g == 3 && m == 3 && fr >= 14) { float* gp = gl + ((size_t)(u.pm * 2 + (fr - 14))) * CF + ch0; *(f32x4*)gp = acc[ai][0][m][0]; *(f32x4*)(gp + 4) = acc[ai][0][m][1]; }
#pragma unroll
                for (int n = 0; n < 2; ++n) prev[n] = acc[ai][0][m][n];
            }
        }
    }
};
template <class Epi, class Sched, bool ALIGN_EPI = false, bool SP2 = false>
__device__ __forceinline__ void gemm_phase(PG8_LAS unsigned char* lds, const Gemm g, const Sched& S, const Epi& E) {
    const int tid = threadIdx.x, wid = __builtin_amdgcn_readfirstlane(tid >> 6), lane = tid & 63, wr = wid >> 2, wc = wid & 3, fr = lane & 15, fq = lane >> 4;
    const int K = g.K, nt = K / BK;
    unsigned voffA[2], voffB[2];
#pragma unroll
    for (int i = 0; i < 2; ++i) { int R, C; stage_rc(tid * 16 + i * 8192, R, C); const int Rb = Epi::PERM ? ((R & ~31) + perm32(R & 31)) : R;
        voffA[i] = (unsigned)(R * K + C) * 2u; voffB[i] = (unsigned)(Rb * K + C) * 2u; }
    const size_t kstep = (size_t)(BK * 2);
    const size_t hstep = (size_t)HALF * K * 2;
    const size_t tstep = 2 * hstep;
    const unsigned ldsw = (unsigned)wid * 1024u;
    const int aoff = lds_byte(wr * 64 + fr, fq * 8), boff = lds_byte(wc * 32 + fr, fq * 8);
#define PG8_SA(b, h) (((b) * 2 + (h)) * HTB)
#define PG8_SB(b, h) ((4 + (b) * 2 + (h)) * HTB)
#define PG8_STAGE(bufoff, gbase, voff) do { _Pragma("unroll") for (int _i = 0; _i < 2; ++_i) \
        __builtin_amdgcn_global_load_lds((const unsigned*)((const char*)(gbase) + (voff)[_i]), (PG8_LAS unsigned*)(lds + (bufoff) + ldsw + _i * 8192), 16, 0, 0); } while (0)
#define PG8_LDA(dst, b, h) do { _Pragma("unroll") for (int m = 0; m < 4; ++m) _Pragma("unroll") for (int k = 0; k < 2; ++k) dst[m][k] = *(const PG8_LAS bf16x8*)(lds + PG8_SA(b, h) + aoff + m * 2048 + k * 1024); } while (0)
#define PG8_LDB(dst, b, h) do { _Pragma("unroll") for (int n = 0; n < 2; ++n) _Pragma("unroll") for (int k = 0; k < 2; ++k) dst[n][k] = *(const PG8_LAS bf16x8*)(lds + PG8_SB(b, h) + boff + n * 2048 + k * 1024); } while (0)
#define PG8_MMA(ai, bj, At, Bt) do { __builtin_amdgcn_s_setprio(1); _Pragma("unroll") for (int m = 0; m < 4; ++m) _Pragma("unroll") for (int n = 0; n < 2; ++n) _Pragma("unroll") for (int k = 0; k < 2; ++k) \
        acc[ai][bj][m][n] = __builtin_amdgcn_mfma_f32_16x16x32_bf16(Bt[n][k], At[m][k], acc[ai][bj][m][n], 0, 0, 0); __builtin_amdgcn_s_setprio(0); } while (0)
#define PG8_WAIT_V(n) asm volatile("s_waitcnt vmcnt(" #n ")" ::: "memory")
#define PG8_WAIT_V8R(rl) asm volatile("s_cmp_lg_u32 %0, 0\n\ts_cbranch_scc1 .Lpg8w%=\n\ts_waitcnt vmcnt(8)\n.Lpg8w%=:\n\ts_waitcnt vmcnt(%1)" :: "s"(__builtin_amdgcn_readfirstlane(rl)), "i"(8 + Epi::NST) : "memory", "scc")
#define PG8_WAIT_L(n) asm volatile("s_waitcnt lgkmcnt(" #n ")" ::: "memory")
#define PG8_BAR __builtin_amdgcn_s_barrier()
#define PG8_SCHED __builtin_amdgcn_sched_barrier(0)
    Unit cur, nxt; int ui = 0;
    if (!S.next(0, cur)) return;
    f32x4 acc[2][2][4][2];
#pragma unroll
    for (int a = 0; a < 2; ++a)
#pragma unroll
        for (int b = 0; b < 2; ++b)
#pragma unroll
            for (int m = 0; m < 4; ++m)
#pragma unroll
                for (int n = 0; n < 2; ++n) acc[a][b][m][n] = (f32x4){0.f, 0.f, 0.f, 0.f};
    bf16x8 At[4][2], B0[2][2], B1[2][2];
    const char* cA = (const char*)g.A + (size_t)cur.pm * tstep; const char* cB = (const char*)g.Bt + (size_t)cur.pn * tstep;
    S.a_ready(cur);
    if constexpr (SP2) {
        PG8_STAGE(PG8_SB(0, 0), cB, voffB); PG8_STAGE(PG8_SB(0, 1), cB + hstep, voffB); PG8_STAGE(PG8_SA(0, 0), cA, voffA); PG8_STAGE(PG8_SA(0, 1), cA + hstep, voffA);
        if (wr == 1) PG8_BAR;
        PG8_WAIT_V(2); PG8_BAR;
        PG8_STAGE(PG8_SB(1, 0), cB + kstep, voffB); PG8_STAGE(PG8_SA(1, 0), cA + kstep, voffA); PG8_STAGE(PG8_SB(1, 1), cB + hstep + kstep, voffB);
        PG8_WAIT_V(6); PG8_BAR;
    } else {
        PG8_STAGE(PG8_SB(0, 0), cB, voffB); PG8_STAGE(PG8_SA(0, 0), cA, voffA); PG8_STAGE(PG8_SB(0, 1), cB + hstep, voffB); PG8_STAGE(PG8_SA(0, 1), cA + hstep, voffA);
        if (wr == 1) PG8_BAR;
        PG8_WAIT_V(4); PG8_BAR;
        PG8_STAGE(PG8_SB(1, 0), cB + kstep, voffB); PG8_STAGE(PG8_SA(1, 0), cA + kstep, voffA); PG8_STAGE(PG8_SB(1, 1), cB + hstep + kstep, voffB);
        PG8_WAIT_V(6); PG8_BAR;
    }
    for (;;) {
        const bool has_next = S.next(ui + 1, nxt);
        const char* nA = has_next ? (const char*)g.A + (size_t)nxt.pm * tstep : cA; const char* nB = has_next ? (const char*)g.Bt + (size_t)nxt.pn * tstep : cB;
        for (int t = 0; t < nt; t += 2) {
            const bool last = (t == nt - 2);
            const int relax = (ui > 0 && t == 0) ? 1 : 0;
            const char* a1 = cA + (size_t)(t + 1) * kstep;
            const char* a2 = last ? nA : cA + (size_t)(t + 2) * kstep; const char* b2 = last ? nB : cB + (size_t)(t + 2) * kstep;
            const char* a3 = a2 + kstep; const char* b3 = b2 + kstep;
            if (last && has_next) S.a_ready(nxt);
            if constexpr (SP2) {
            PG8_LDB(B0, 0, 0); PG8_LDB(B1, 0, 1); PG8_SCHED; PG8_LDA(At, 0, 0); PG8_STAGE(PG8_SA(1, 1), a1 + hstep, voffA);
            PG8_WAIT_V8R(relax); PG8_WAIT_L(0); PG8_BAR; PG8_MMA(0, 0, At, B0); PG8_MMA(0, 1, At, B1); PG8_BAR; PG8_SCHED;
            PG8_LDA(At, 0, 1); PG8_STAGE(PG8_SB(0, 0), b2, voffB); PG8_STAGE(PG8_SB(0, 1), b2 + hstep, voffB); PG8_STAGE(PG8_SA(0, 0), a2, voffA);
            PG8_WAIT_V8R(relax); PG8_WAIT_L(0); PG8_BAR; PG8_MMA(1, 0, At, B0); PG8_MMA(1, 1, At, B1); PG8_BAR; PG8_SCHED;
            PG8_LDB(B0, 1, 0); PG8_LDB(B1, 1, 1); PG8_SCHED; PG8_LDA(At, 1, 0); PG8_STAGE(PG8_SA(0, 1), a2 + hstep, voffA);
            PG8_WAIT_V(8); PG8_WAIT_L(0); PG8_BAR; PG8_MMA(0, 0, At, B0); PG8_MMA(0, 1, At, B1); PG8_BAR; PG8_SCHED;
            PG8_LDA(At, 1, 1); PG8_STAGE(PG8_SB(1, 0), b3, voffB); PG8_STAGE(PG8_SB(1, 1), b3 + hstep, voffB); PG8_STAGE(PG8_SA(1, 0), a3, voffA);
            PG8_WAIT_V(8); PG8_WAIT_L(0); PG8_BAR; PG8_MMA(1, 0, At, B0); PG8_MMA(1, 1, At, B1); PG8_BAR; PG8_SCHED;
            } else {
            PG8_LDB(B0, 0, 0); PG8_SCHED; PG8_LDA(At, 0, 0); PG8_STAGE(PG8_SA(1, 1), a1 + hstep, voffA);
            PG8_WAIT_L(8); PG8_BAR; PG8_WAIT_L(0); PG8_MMA(0, 0, At, B0); PG8_BAR; PG8_SCHED;
            PG8_LDB(B1, 0, 1); PG8_STAGE(PG8_SB(0, 0), b2, voffB);
            PG8_BAR; PG8_WAIT_L(0); PG8_MMA(0, 1, At, B1); PG8_BAR;
            PG8_LDA(At, 0, 1); PG8_STAGE(PG8_SA(0, 0), a2, voffA);
            PG8_BAR; PG8_WAIT_L(0); PG8_MMA(1, 0, At, B0); PG8_BAR; PG8_SCHED;
            PG8_STAGE(PG8_SB(0, 1), b2 + hstep, voffB);
            PG8_WAIT_V(6); PG8_BAR; PG8_MMA(1, 1, At, B1); PG8_BAR;
            PG8_LDB(B0, 1, 0); PG8_SCHED; PG8_LDA(At, 1, 0); PG8_STAGE(PG8_SA(0, 1), a2 + hstep, voffA);
            PG8_WAIT_L(8); PG8_BAR; PG8_WAIT_L(0); PG8_MMA(0, 0, At, B0); PG8_BAR; PG8_SCHED;
            PG8_LDB(B1, 1, 1); PG8_STAGE(PG8_SB(1, 0), b3, voffB);
            PG8_BAR; PG8_WAIT_L(0); PG8_MMA(0, 1, At, B1); PG8_BAR;
            PG8_LDA(At, 1, 1); PG8_STAGE(PG8_SA(1, 0), a3, voffA);
            PG8_BAR; PG8_WAIT_L(0); PG8_MMA(1, 0, At, B0); PG8_BAR; PG8_SCHED;
            PG8_STAGE(PG8_SB(1, 1), b3 + hstep, voffB);
            PG8_WAIT_V(6); PG8_BAR; PG8_MMA(1, 1, At, B1); PG8_BAR;
            }
        }
        if constexpr (ALIGN_EPI) { if (wr == 0) PG8_BAR; }
        if constexpr (!Epi::AFTER_DRAIN) { E(acc, cur, wr, wc, fr, fq); S.done(cur); }
        if (!has_next) break;
#pragma unroll
        for (int a = 0; a < 2; ++a)
#pragma unroll
            for (int b = 0; b < 2; ++b)
#pragma unroll
                for (int m = 0; m < 4; ++m)
#pragma unroll
                    for (int n = 0; n < 2; ++n) acc[a][b][m][n] = (f32x4){0.f, 0.f, 0.f, 0.f};
        cur = nxt; cA = nA; cB = nB; ++ui;
        if constexpr (ALIGN_EPI) { if (wr == 1) PG8_BAR; }
    }
    PG8_WAIT_V(0);
    if constexpr (!ALIGN_EPI) { if (wr == 0) PG8_BAR; }
    PG8_BAR;
    if constexpr (Epi::AFTER_DRAIN) { E.fused(acc, cur, wr, wc, fr, fq, lds, wid, lane); S.done(cur); }
#undef PG8_SA
#undef PG8_SB
#undef PG8_STAGE
#undef PG8_LDA
#undef PG8_LDB
#undef PG8_MMA
#undef PG8_WAIT_V
#undef PG8_WAIT_V8R
#undef PG8_WAIT_L
#undef PG8_BAR
#undef PG8_SCHED
}
}
namespace att {
constexpr int D = 128, LDQ = 1024, NW = 8, QBLK = 32, KVBLK = 64, QB = NW * QBLK;
constexpr int SHM_V = KVBLK * D * 2, SHM_K = KVBLK * D * 2;
constexpr int OFF_V = 0, OFF_K = 3 * SHM_V, OFF_WS = OFF_K + 2 * SHM_K, OFF_BIAS = OFF_WS + NW * 64 * 4, OFF_O = OFF_BIAS + 2 * 64 * 4, LDS_BYTES = OFF_O + NW * 8192;
constexpr float SCALE = 0.08838834764831845f, THR = 8.f;
typedef unsigned short bf16;
typedef short bf16x8 __attribute__((ext_vector_type(8)));
typedef short s16x4 __attribute__((ext_vector_type(4)));
typedef float f32x16 __attribute__((ext_vector_type(16)));
typedef float f32x4 __attribute__((ext_vector_type(4)));
typedef unsigned u32x4 __attribute__((ext_vector_type(4)));
#define ALAS __attribute__((address_space(3)))
#define KSWZ(row, colB) ((row) * 256 + ((colB) ^ (((row) & 7) << 4)))
#define SBAR() __builtin_amdgcn_sched_barrier(0)
__device__ __forceinline__ int v_st(int k, int c) { const int kk = (k & ~0xC) | ((k & 4) << 1) | ((k & 8) >> 1); return ((kk >> 3) * 4 + (c >> 5)) * 512 + ((kk & 7) * 32 + (c & 31)) * 2; }
__device__ __forceinline__ int v_rd_base(int lane) { return ((lane & 3) << 3) | (((lane >> 2) & 3) << 6) | (((lane >> 4) & 1) << 5) | (((lane >> 5) & 1) << 8); }
constexpr int v_rd_off(int d0, int ks, int half) { return d0 * 512 + ks * 4096 + half * 2048; }
__device__ __forceinline__ int crow(int r, int hi) { return (r & 3) + 8 * (r >> 2) + 4 * hi; }
__device__ __forceinline__ unsigned cvtpk(float lo, float hi) { unsigned r; asm volatile("v_cvt_pk_bf16_f32 %0, %1, %2" : "=v"(r) : "v"(lo), "v"(hi)); return r; }
__device__ __forceinline__ bf16x8 load8(const bf16* p) { return *reinterpret_cast<const bf16x8*>(p); }
__device__ __forceinline__ void mask_tile(f32x16& p0, f32x16& p1, int dq, unsigned W) {
    const float NEG = -__builtin_inff();
#pragma unroll
    for (int r = 0; r < 16; ++r) {
        const int c = (r & 3) + 8 * (r >> 2);
        if ((unsigned)(dq - c) >= W) p0[r] = NEG;
        if ((unsigned)(dq - c - 32) >= W) p1[r] = NEG;
    }
}
__device__ __forceinline__ void partialSM(f32x16& p0, f32x16& p1, float& m_reg, float& mn, float& alpha) {
    float pmax = p0[0]; for (int r = 1; r < 16; ++r) pmax = fmaxf(pmax, p0[r]); for (int r = 0; r < 16; ++r) pmax = fmaxf(pmax, p1[r]);
    { auto rr = __builtin_amdgcn_permlane32_swap(__float_as_uint(pmax), __float_as_uint(pmax), false, false);
      pmax = fmaxf(__uint_as_float(rr[0]), __uint_as_float(rr[1])); }
    constexpr float C2 = 1.4426950408889634f * SCALE;
    if (__builtin_expect(__all((pmax - m_reg) * SCALE <= THR), 1)) { mn = m_reg; alpha = 1.f; }
    else { mn = fmaxf(m_reg, pmax); alpha = __builtin_amdgcn_exp2f((m_reg - mn) * C2); m_reg = mn; }
    const float mnL = -mn * C2;
    for (int r = 0; r < 16; ++r) p0[r] = fmaf(p0[r], C2, mnL); for (int r = 0; r < 16; ++r) p1[r] = fmaf(p1[r], C2, mnL);
    for (int r = 0; r < 16; ++r) p0[r] = __builtin_amdgcn_exp2f(p0[r]);
}
__device__ __forceinline__ void finishSM(f32x16& p0, f32x16& p1, float alpha, float& l_reg, bf16x8& pa0, bf16x8& pa1, bf16x8& pa2, bf16x8& pa3) {
    for (int r = 0; r < 16; ++r) p1[r] = __builtin_amdgcn_exp2f(p1[r]);
    float ps = 0; for (int r = 0; r < 16; ++r) ps += p0[r]; for (int r = 0; r < 16; ++r) ps += p1[r];
    { auto rr = __builtin_amdgcn_permlane32_swap(__float_as_uint(ps), __float_as_uint(ps), false, false);
      ps = __uint_as_float(rr[0]) + __uint_as_float(rr[1]); }
    l_reg = l_reg * alpha + ps;
#define PK4(P, B_, OUT) do { unsigned a0 = cvtpk(P[B_+0], P[B_+1]), a1 = cvtpk(P[B_+2], P[B_+3]);                          \
        unsigned b0 = cvtpk(P[B_+4], P[B_+5]), b1 = cvtpk(P[B_+6], P[B_+7]);                                             \
        auto r0 = __builtin_amdgcn_permlane32_swap(a0, b0, false, false); auto r1 = __builtin_amdgcn_permlane32_swap(a1, b1, false, false); \
        u32x4 w = {r0[0], r1[0], r0[1], r1[1]}; OUT = *reinterpret_cast<bf16x8*>(&w); } while (0)
    PK4(p0, 0, pa0); PK4(p0, 8, pa1); PK4(p1, 0, pa2); PK4(p1, 8, pa3);
#undef PK4
}
template <int KB>
__device__ __forceinline__ void qkt(f32x16& p0, f32x16& p1, const ALAS char* K_lds, const ALAS float* bias_l, int r32, int hi, const bf16x8* qr) {
    const ALAS float* bl = bias_l + KB * 64 + 4 * hi;
#pragma unroll
    for (int g = 0; g < 4; ++g) { const f32x4 t0 = *(const ALAS f32x4*)(bl + 8 * g), t1 = *(const ALAS f32x4*)(bl + 32 + 8 * g);
#pragma unroll
        for (int i = 0; i < 4; ++i) { p0[4 * g + i] = t0[i]; p1[4 * g + i] = t1[i]; } }
    const ALAS char* kb[4];
#pragma unroll
    for (int dd = 0; dd < 4; ++dd) kb[dd] = K_lds + KB * SHM_K + KSWZ(r32, (dd * 16 + hi * 8) * 2);
#pragma unroll
    for (int d0 = 0; d0 < 8; ++d0) { const ALAS char* a = kb[d0 & 3] + (d0 >> 2) * 128;
        bf16x8 b0 = *(const ALAS bf16x8*)(a);
        bf16x8 b1 = *(const ALAS bf16x8*)(a + 32 * 256);
        const bf16x8 qv = qr[d0];
        p0 = __builtin_amdgcn_mfma_f32_32x32x16_bf16(b0, qv, p0, 0, 0, 0);
        p1 = __builtin_amdgcn_mfma_f32_32x32x16_bf16(b1, qv, p1, 0, 0, 0); }
}
template <int VB>
__device__ __forceinline__ void pv_tile(f32x16* o, int vb0, bf16x8 pa0, bf16x8 pa1, bf16x8 pa2, bf16x8 pa3) {
#define TRRD(dst, off) asm volatile("ds_read_b64_tr_b16 %0, %1 offset:%2" : "=&v"(dst) : "v"(vb0), "i"(off) : "memory")
#define PV_D0(d0) do { s16x4 l0, l1, l2, l3, h0, h1, h2, h3; constexpr int b_ = VB * SHM_V + v_rd_off(d0, 0, 0);   \
        TRRD(l0, b_); TRRD(h0, b_ + 2048); TRRD(l1, b_ + 4096); TRRD(h1, b_ + 6144); TRRD(l2, b_ + 8192); TRRD(h2, b_ + 10240); TRRD(l3, b_ + 12288); TRRD(h3, b_ + 14336); \
        asm volatile("s_waitcnt lgkmcnt(0)" ::: "memory"); SBAR();   \
        o[d0] = __builtin_amdgcn_mfma_f32_32x32x16_bf16(pa0, (bf16x8){l0[0], l0[1], l0[2], l0[3], h0[0], h0[1], h0[2], h0[3]}, o[d0], 0, 0, 0);   \
        o[d0] = __builtin_amdgcn_mfma_f32_32x32x16_bf16(pa1, (bf16x8){l1[0], l1[1], l1[2], l1[3], h1[0], h1[1], h1[2], h1[3]}, o[d0], 0, 0, 0);   \
        o[d0] = __builtin_amdgcn_mfma_f32_32x32x16_bf16(pa2, (bf16x8){l2[0], l2[1], l2[2], l2[3], h2[0], h2[1], h2[2], h2[3]}, o[d0], 0, 0, 0);   \
        o[d0] = __builtin_amdgcn_mfma_f32_32x32x16_bf16(pa3, (bf16x8){l3[0], l3[1], l3[2], l3[3], h3[0], h3[1], h3[2], h3[3]}, o[d0], 0, 0, 0); } while (0)
    PV_D0(0); PV_D0(1); PV_D0(2); PV_D0(3);
#undef PV_D0
#undef TRRD
}
struct BlockRef { const bf16* Q; const bf16* K; const bf16* V; bf16* O; const float* NB; int P0; };
struct Seam { bf16x8 qr[8]; int vslot; };
#define WAITB() do { asm volatile("s_waitcnt vmcnt(0) lgkmcnt(0)" ::: "memory"); __builtin_amdgcn_s_barrier(); asm volatile("" ::: "memory"); } while (0)
#define DMA_TILE(Kp, Vp, NBp, k0, kb, vs) do { const bf16* kp_ = (Kp) + (unsigned)((k0) * LDQ); const bf16* vp_ = (Vp) + (unsigned)((k0) * LDQ);                                   \
        __builtin_amdgcn_global_load_lds((const unsigned*)(kp_ + koff0), (ALAS unsigned*)(K_lds + (kb) * SHM_K + wid * 2048), 16, 0, 0);                                         \
        __builtin_amdgcn_global_load_lds((const unsigned*)(kp_ + koff1), (ALAS unsigned*)(K_lds + (kb) * SHM_K + wid * 2048 + 1024), 16, 0, 0);                                  \
        __builtin_amdgcn_global_load_lds((const unsigned*)(vp_ + voff0), (ALAS unsigned*)(V_lds + (vs) * SHM_V + wid * 2048), 16, 0, 0);                                         \
        __builtin_amdgcn_global_load_lds((const unsigned*)(vp_ + voff1), (ALAS unsigned*)(V_lds + (vs) * SHM_V + wid * 2048 + 1024), 16, 0, 0);                                  \
        if (wid == 0) __builtin_amdgcn_global_load_lds((const unsigned*)((NBp) + (unsigned)((k0) + lane)), (ALAS unsigned*)(bias_l + (kb) * 64), 4, 0, 0); } while (0)
#define DMA_OFFSETS() unsigned koff0, koff1, voff0, voff1;                                                                                                                       \
    { const int c0 = 2 * wid, c1 = c0 + 1, r0_ = 4 * c0 + (lane >> 4), r1_ = 4 * c1 + (lane >> 4), p_ = lane & 15;                                                              \
      koff0 = (unsigned)(r0_ * LDQ + ((p_ ^ (r0_ & 7)) * 8)); koff1 = (unsigned)(r1_ * LDQ + ((p_ ^ (r1_ & 7)) * 8));                                                          \
      const int U0 = 64 * c0 + lane, U1 = 64 * c1 + lane;                                                                                                                        \
      { const int s_ = U0 >> 5, kk = (s_ >> 2) * 8 + ((U0 & 31) >> 2), cc = (s_ & 3) * 32 + (U0 & 3) * 8, k_ = (kk & ~0xC) | ((kk & 4) << 1) | ((kk & 8) >> 1); voff0 = (unsigned)(k_ * LDQ + cc); } \
      { const int s_ = U1 >> 5, kk = (s_ >> 2) * 8 + ((U1 & 31) >> 2), cc = (s_ & 3) * 32 + (U1 & 3) * 8, k_ = (kk & ~0xC) | ((kk & 4) << 1) | ((kk & 8) >> 1); voff1 = (unsigned)(k_ * LDQ + cc); } }
__device__ __forceinline__ void prime(const BlockRef& cur, char* lds_g, Seam& S) {
    ALAS char* lds = (ALAS char*)lds_g;
    const int tid = threadIdx.x, wid = __builtin_amdgcn_readfirstlane(tid >> 6), lane = tid & 63, r32 = lane & 31, hi = lane >> 5;
    ALAS char* V_lds = lds + OFF_V; ALAS char* K_lds = lds + OFF_K; ALAS float* bias_l = (ALAS float*)(lds + OFF_BIAS);
    DMA_OFFSETS();
    for (int d0 = 0; d0 < 8; ++d0) S.qr[d0] = load8(cur.Q + (unsigned)((wid * QBLK + r32) * LDQ + d0 * 16 + hi * 8));
    S.vslot = 0;
    DMA_TILE(cur.K, cur.V, cur.NB, 0, 0, 0);
    WAITB();
}
__device__ __forceinline__ void block(const BlockRef& cur, const BlockRef& nxt, char* lds_g, Seam& S) {
    ALAS char* lds = (ALAS char*)lds_g;
    const int tid = threadIdx.x, wid = __builtin_amdgcn_readfirstlane(tid >> 6), lane = tid & 63, r32 = lane & 31, hi = lane >> 5;
    const int W = 1 << 30;
    const int NT = cur.P0 / KVBLK + 4;
    const int qlo = cur.P0 + wid * QBLK, qm = qlo + r32 - 4 * hi;
    ALAS char* V_lds = lds + OFF_V; ALAS char* K_lds = lds + OFF_K; ALAS float* bias_l = (ALAS float*)(lds + OFF_BIAS);
    ALAS float* ws = (ALAS float*)(lds + OFF_WS) + wid * 64; ALAS float* li_l = ws; ALAS float* al_l = ws + 32;
    float m_reg = -1e30f, l_reg = 0; f32x16 o[4] = {};
    DMA_OFFSETS();
    const int vb0 = (int)(unsigned)(__SIZE_TYPE__)V_lds + v_rd_base(lane);
    const bf16* Kh = cur.K; const bf16* Vh = cur.V; const float* NBh = cur.NB;
    int sA = S.vslot, sB = (sA == 2) ? 0 : sA + 1, sC = (sB == 2) ? 0 : sB + 1;
#define ROT() do { sA = sB; sB = sC; sC = (sC == 2) ? 0 : sC + 1; } while (0)
#define RESC(a) do { if (__any((a) < 1.f)) { if (hi == 0) al_l[r32] = (a); asm volatile("s_waitcnt lgkmcnt(0)" ::: "memory");              \
                     for (int d_ = 0; d_ < 4; ++d_) for (int r = 0; r < 16; ++r) o[d_][r] *= al_l[crow(r, hi)]; } } while (0)
#define KBASE(t) ((t) * KVBLK)
#define MASKT(P0_, P1_, t) do { const int kb_ = KBASE(t); if (kb_ + KVBLK - 1 > qlo) mask_tile(P0_, P1_, qm - kb_, (unsigned)W); } while (0)
    f32x16 pA0, pA1, pB0, pB1; float mnA, mnB, alA, alB; bf16x8 pa0, pa1, pa2, pa3;
    DMA_TILE(Kh, Vh, NBh, KBASE(1), 1, sB);
    SBAR(); qkt<0>(pA0, pA1, K_lds, bias_l, r32, hi, S.qr);
    MASKT(pA0, pA1, 0); partialSM(pA0, pA1, m_reg, mnA, alA);
    WAITB();
#define HALF_STEP(PX0, PX1, mnX, alX, PY0, PY1, alY, t, KB) do {                                                              \
        SBAR(); qkt<KB>(PX0, PX1, K_lds, bias_l, r32, hi, S.qr);                                                              \
        finishSM(PY0, PY1, alY, l_reg, pa0, pa1, pa2, pa3); SBAR();                                                           \
        if ((t) + 1 < NT) { DMA_TILE(Kh, Vh, NBh, KBASE((t) + 1), 1 - KB, sC); SBAR(); }                                      \
        pv_tile<0>(o, vb0 + sA * SHM_V, pa0, pa1, pa2, pa3); MASKT(PX0, PX1, (t)); partialSM(PX0, PX1, m_reg, mnX, alX);      \
        RESC(alX); WAITB(); ROT(); } while (0)
    for (int t = 1; t + 1 < NT; t += 2) {
        HALF_STEP(pB0, pB1, mnB, alB, pA0, pA1, alA, t, 1);
        HALF_STEP(pA0, pA1, mnA, alA, pB0, pB1, alB, t + 1, 0);
    }
    SBAR(); qkt<1>(pB0, pB1, K_lds, bias_l, r32, hi, S.qr); SBAR();
    { unsigned zo = 0; asm volatile("" : "+s"(zo));
      const bf16* nK = nxt.K + zo; const bf16* nV = nxt.V + zo; const float* nN = nxt.NB + zo; const bf16* nQ = nxt.Q + zo;
      DMA_TILE(nK, nV, nN, 0, 0, sC); SBAR();
#pragma unroll
      for (int d0 = 0; d0 < 8; ++d0) S.qr[d0] = load8(nQ + (unsigned)((wid * QBLK + r32) * LDQ + d0 * 16 + hi * 8)); }
    SBAR();
    finishSM(pA0, pA1, alA, l_reg, pa0, pa1, pa2, pa3); SBAR();
    pv_tile<0>(o, vb0 + sA * SHM_V, pa0, pa1, pa2, pa3);
    MASKT(pB0, pB1, NT - 1); partialSM(pB0, pB1, m_reg, mnB, alB); RESC(alB);
    finishSM(pB0, pB1, alB, l_reg, pa0, pa1, pa2, pa3); SBAR(); pv_tile<0>(o, vb0 + sB * SHM_V, pa0, pa1, pa2, pa3);
    S.vslot = sC;
    if (hi == 0) li_l[r32] = l_reg; asm volatile("s_waitcnt lgkmcnt(0)" ::: "memory");
    float rli[16];
#pragma unroll
    for (int r = 0; r < 16; ++r) rli[r] = __builtin_amdgcn_rcpf(li_l[crow(r, hi)]);
    unsigned zo2 = 0; asm volatile("" : "+s"(zo2)); bf16* ob = cur.O + zo2;
    bf16* Ow = ob + (unsigned)((wid * QBLK) * LDQ);
    { int ln = lane; asm volatile("" : "+v"(ln));
      ALAS bf16* stg = (ALAS bf16*)(lds + OFF_O + wid * 8192);
#pragma unroll
      for (int r = 0; r < 16; ++r) { const int orow = crow(r, hi);
#pragma unroll
          for (int d0 = 0; d0 < 4; ++d0) { const float v = o[d0][r] * rli[r]; stg[orow * 128 + d0 * 32 + r32] = (bf16)(cvtpk(v, v) & 0xffffu); } }
      asm volatile("s_waitcnt lgkmcnt(0)" ::: "memory");
#pragma unroll
      for (int i = 0; i < 8; ++i) { const int row = i * 4 + (ln >> 4), ch = ln & 15;
          const u32x4 w = *(const ALAS u32x4*)(stg + row * 128 + ch * 8);
          *(u32x4*)(Ow + (unsigned)(row * LDQ + ch * 8)) = w; if (i & 1) asm volatile("" ::: "memory"); }
      asm volatile("s_waitcnt lgkmcnt(0)" ::: "memory"); }
    WAITB();
#undef RESC
#undef KBASE
#undef MASKT
#undef HALF_STEP
#undef ROT
}
#undef DMA_TILE
#undef DMA_OFFSETS
#undef WAITB
#undef KSWZ
#undef SBAR
}
namespace cg = cooperative_groups;
constexpr int NB_ = 32, S_ = 2048, DM = 1024, T_ = NB_ * S_;
constexpr int DR = 1280, DFF = 3072, DIN = 7688, NZ = 7680;
constexpr int ZC_FL = 5632, ZC_MG = 5640;
constexpr float RMS_EPS = 1e-6f;
constexpr size_t MiB = 1u << 20;
constexpr size_t WS_MOD = 1 * MiB, WS_MODF = 2 * MiB, WS_NB = 3 * MiB, WS_LOGF = 5 * MiB;
constexpr size_t WS_WIN = 8 * MiB, WS_WUP = 23 * MiB, WS_WDN = 35 * MiB, WS_WPR = 41 * MiB, WS_WPA = 44 * MiB, WS_WOUT = 46 * MiB, WS_WA = 48 * MiB, WS_WI = 49 * MiB;
constexpr size_t WS_H = 64 * MiB;
constexpr size_t WS_XR = 192 * MiB, WS_GR = 352 * MiB, WS_Q = 512 * MiB, WS_K = 640 * MiB, WS_V = 768 * MiB;
constexpr size_t WS_GF = 192 * MiB, WS_UF = 576 * MiB, WS_END = 960 * MiB;
constexpr size_t WS_PRE = 192 * MiB, WS_UF2 = 200 * MiB, WS_GL = 208 * MiB;
static_assert(pg8::E_XR == WS_XR && pg8::E_GR == WS_GR && pg8::E_Q == WS_Q && pg8::E_K == WS_K && pg8::E_V == WS_V && pg8::E_GF == WS_GF && pg8::E_UF == WS_UF, "epilogue segment map");
constexpr int LDS_BYTES = 163840, NTHR = 512, NWV = 8;
#define LAS __attribute__((address_space(3)))
typedef unsigned short bf16;
typedef float f32x4 __attribute__((ext_vector_type(4)));
typedef unsigned u32x4 __attribute__((ext_vector_type(4)));
typedef short bf16x8 __attribute__((ext_vector_type(8)));
#define LDS_WAIT() asm volatile("s_waitcnt lgkmcnt(0)" ::: "memory")
constexpr int MISC_OFF = LDS_BYTES - 64;
constexpr size_t CTL_ZERO_BYTES = 65536;
#define XB_TMO      128
#define XB_XCNT(j)  (256  + 64 * (j))
#define XB_XSUB(j)  (1280 + 64 * (j))
#define XB_XGEN(j)  (2304 + 64 * (j))
#define XB_TOP      3328
#define XB_TOPGEN   3392
#define XCD_BAR_WORDS 3456
#define XB_SPIN_CAP (1u << 18)

__device__ __forceinline__ unsigned xb_ld(unsigned* p)              { return __hip_atomic_load(p, __ATOMIC_RELAXED, __HIP_MEMORY_SCOPE_AGENT); }
__device__ __forceinline__ unsigned xb_add(unsigned* p, unsigned v) { return __hip_atomic_fetch_add(p, v, __ATOMIC_RELAXED, __HIP_MEMORY_SCOPE_AGENT); }
__device__ __forceinline__ unsigned xb_xcc_id() { return (unsigned)__builtin_amdgcn_s_getreg((3 << 11) | 20) & 0xFu; }
#define XB_SPIN(cond, bar) do { unsigned _sp = 0; while (cond) { __builtin_amdgcn_s_sleep(1); \
    if ((++_sp & 255u) == 0u) { if (xb_ld(&(bar)[XB_TMO])) break; if (_sp > XB_SPIN_CAP) { atomicAdd(&(bar)[XB_TMO], 1u); break; } } } } while (0)

struct XcdBarrier {
    unsigned* bar; unsigned x;
    volatile LAS unsigned* st;
};

__device__ __forceinline__ XcdBarrier xcd_barrier_post(unsigned* bar, volatile LAS unsigned* st) {
    XcdBarrier b; b.bar = bar; b.x = xb_xcc_id(); b.st = st;
    if (threadIdx.x == 0) (void)xb_add(&bar[XB_XCNT(b.x)], 1u);
    return b;
}
__device__ __forceinline__ void xcd_barrier_complete(unsigned* bar, unsigned x, unsigned& nloc, unsigned& nx) {
    const unsigned G = gridDim.x * gridDim.y * gridDim.z;
    unsigned sum, cnt, mine, sp = 0u;
    for (;;) {
        sum = 0u; cnt = 0u; mine = 0u;
#pragma unroll
        for (unsigned j = 0; j < 16; ++j) { const unsigned c = xb_ld(&bar[XB_XCNT(j)]); sum += c; cnt += (c > 0u) ? 1u : 0u; mine = (j == x) ? c : mine; }
        if (sum == G) break;
        __builtin_amdgcn_s_sleep(1);
        if ((++sp & 255u) == 0u) { if (xb_ld(&bar[XB_TMO])) break; if (sp > XB_SPIN_CAP) { atomicAdd(&bar[XB_TMO], 1u); break; } }
    }
    nloc = mine > 0u ? mine : 1u; nx = cnt > 0u ? cnt : 1u;
}

__device__ __forceinline__ void xcd_barrier(const XcdBarrier& b) {
    asm volatile("s_waitcnt vmcnt(0)" ::: "memory");
    __syncthreads();
    if (threadIdx.x == 0) {
        unsigned* bar = b.bar;
        __builtin_amdgcn_s_waitcnt(0);
        unsigned nloc = b.st[0], nx = b.st[1];
        if (nloc == 0u) { xcd_barrier_complete(bar, b.x, nloc, nx); b.st[0] = nloc; b.st[1] = nx; }
        const unsigned old = xb_add(&bar[XB_XSUB(b.x)], 1u);
        const unsigned gen = old / nloc;
        if (old + 1u == (gen + 1u) * nloc) {
            __builtin_amdgcn_fence(__ATOMIC_RELEASE, "agent");
            asm volatile("s_waitcnt vmcnt(0)" ::: "memory");
            const unsigned og = xb_add(&bar[XB_TOP], 1u);
            const unsigned tg = og / nx;
            if (og + 1u == (tg + 1u) * nx) xb_add(&bar[XB_TOPGEN], 1u);
            else XB_SPIN(xb_ld(&bar[XB_TOPGEN]) == tg, bar);
            __builtin_amdgcn_fence(__ATOMIC_ACQUIRE, "agent");
            xb_add(&bar[XB_XGEN(b.x)], 1u);
            asm volatile("s_waitcnt vmcnt(0)" ::: "memory");
        } else {
            XB_SPIN(xb_ld(&bar[XB_XGEN(b.x)]) == gen, bar);
            __builtin_amdgcn_fence(__ATOMIC_ACQUIRE, "agent");
            asm volatile("s_waitcnt vmcnt(0)" ::: "memory");
        }
    }
    __syncthreads();
}

struct Args {
    const float *x, *c, *w_ada, *b_ada, *g1, *w_in, *w_rconv, *b_rconv, *w_la, *b_la, *w_li, *b_li, *lam, *b_fg, *w_pr, *w_pa, *w_out, *g2, *w_up, *w_fconv, *b_fconv, *w_dn, *w_adaf, *b_adaf, *gfin;
    float* out; unsigned char* ws; int ph_lo, ph_hi, use_cg, pad;
};

__device__ __forceinline__ float wave_sum(float v) {
#pragma unroll
    for (int o = 1; o < 64; o <<= 1) v += __shfl_xor(v, o);
    return v;
}
__device__ __forceinline__ unsigned pk2(float lo, float hi) { return pg8::cvt_pk_bf16(lo, hi); }
__device__ __forceinline__ float gelu_tanh(float x) {
    const float u = x * (1.0f + 0.044715f * x * x);
    return x * __builtin_amdgcn_rcpf(1.0f + __builtin_amdgcn_exp2f(-2.302208198f * u));
}
__device__ __forceinline__ float sigm(float x) { return __builtin_amdgcn_rcpf(1.0f + __builtin_amdgcn_exp2f(-1.4426950408889634f * x)); }

__device__ __forceinline__ void transpose_item(const float* W, int ldw, int col0, bf16* WT, int K, int row0, int nblk, LAS float* scr, int item, int lane) {
    const int kb = item / nblk, nb = item % nblk, k0 = 64 * kb, n0 = 32 * nb;
#pragma unroll 8
    for (int i = 0; i < 32; ++i) { const int kk = 2 * i + (lane >> 5); scr[kk * 33 + (lane & 31)] = W[(size_t)(k0 + kk) * ldw + col0 + n0 + (lane & 31)]; }
    LDS_WAIT(); asm volatile("" ::: "memory");
    const int c = lane & 7;
#pragma unroll
    for (int j = 0; j < 4; ++j) { const int n = (lane >> 3) + 8 * j; const LAS float* s = scr + (8 * c) * 33 + n;
        u32x4 o; o.x = pk2(s[0 * 33], s[1 * 33]); o.y = pk2(s[2 * 33], s[3 * 33]); o.z = pk2(s[4 * 33], s[5 * 33]); o.w = pk2(s[6 * 33], s[7 * 33]);
        *(u32x4*)(WT + (size_t)(row0 + n0 + n) * K + k0 + 8 * c) = o; }
    LDS_WAIT(); asm volatile("" ::: "memory");
}

__device__ __forceinline__ void mod_item(const Args& a, int item, unsigned char* lds_g) {
    float* cact = (float*)lds_g;
    const int tid = threadIdx.x, col = tid & 31, ks = tid >> 5;
    for (int e = tid; e < NB_ * DM; e += NTHR) { const int b = e >> 10, k = e & 1023; const float v = a.c[e]; cact[k * 32 + b] = v * sigm(v); }
    __syncthreads();
    const int j0 = item * 32; const bool fin = j0 >= 6 * DM;
    const float* W = fin ? a.w_adaf : a.w_ada; const int ldw = fin ? 2 * DM : 6 * DM; const int jb = fin ? j0 - 6 * DM : j0;
    float acc[32];
#pragma unroll
    for (int b = 0; b < 32; ++b) acc[b] = 0.f;
    const float* wp = W + (size_t)(ks * 64) * ldw + jb + col;
#pragma unroll 1
    for (int kk = 0; kk < 64; kk += 16) {
        float wv[16];
#pragma unroll
        for (int u = 0; u < 16; ++u) wv[u] = wp[(size_t)(kk + u) * ldw];
#pragma unroll
        for (int u = 0; u < 16; ++u) { const float* cr = cact + (ks * 64 + kk + u) * 32;
#pragma unroll
            for (int q = 0; q < 8; ++q) { const f32x4 cv = *(const f32x4*)(cr + 4 * q);
                acc[4 * q + 0] += cv[0] * wv[u]; acc[4 * q + 1] += cv[1] * wv[u]; acc[4 * q + 2] += cv[2] * wv[u]; acc[4 * q + 3] += cv[3] * wv[u]; } }
    }
    __syncthreads();
    float* red = (float*)lds_g;
#pragma unroll
    for (int b = 0; b < 32; ++b) red[(ks * 32 + b) * 32 + col] = acc[b];
    __syncthreads();
    float* O = (float*)(a.ws + (fin ? WS_MODF : WS_MOD)); const int ldo = fin ? 2 * DM : 6 * DM;
    const float* bias = fin ? a.b_adaf : a.b_ada;
#pragma unroll
    for (int i = 0; i < 2; ++i) { const int o = tid + NTHR * i, b = o >> 5, c = o & 31; float s = bias[jb + c];
#pragma unroll
        for (int k2 = 0; k2 < 16; ++k2) s += red[(k2 * 32 + b) * 32 + c];
        O[(size_t)b * ldo + jb + c] = s; }
    __syncthreads();
}

template <bool FL, bool F32OUT, bool BF16IN = false>
__device__ __forceinline__ void norm_rows(const float* X, const float* g, const float* shift, const float* scale, int mod_ld, bf16* Hout, float* Fout,
                                          const float* w_in, const float* b_fg, float* logf, int gw, int ngw, float* wfl_l) {
    const int lane = threadIdx.x & 63;
    if (FL) {
        for (int e = threadIdx.x; e < 8 * DM; e += NTHR) { const int k = e >> 3, q = e & 7; wfl_l[q * DM + k] = w_in[(size_t)k * DIN + ZC_FL + q]; }
        __syncthreads();
    }
    for (int r0 = gw * 32; r0 < T_; r0 += ngw * 32) {
        const int b = r0 >> 11;
        f32x4 gs[4], sh[4];
#pragma unroll
        for (int j = 0; j < 4; ++j) { const int k = 4 * lane + 256 * j; const f32x4 gg = *(const f32x4*)(g + k), sc = *(const f32x4*)(scale + (size_t)b * mod_ld + k);
            gs[j] = gg * (sc + 1.0f); sh[j] = *(const f32x4*)(shift + (size_t)b * mod_ld + k); }
        f32x4 nf[4]; unsigned long long nb[4];
#define NR_LOAD(rw) do { if (BF16IN) { const unsigned long long* xb = (const unsigned long long*)((const bf16*)X + (size_t)(rw) * DM) + lane; _Pragma("unroll") for (int j = 0; j < 4; ++j) nb[j] = xb[64 * j]; } \
                         else { const f32x4* xr = (const f32x4*)(X + (size_t)(rw) * DM) + lane; _Pragma("unroll") for (int j = 0; j < 4; ++j) nf[j] = xr[64 * j]; } } while (0)
        NR_LOAD(r0);
        for (int rr = 0; rr < 32; ++rr) {
            const int row = r0 + rr;
            f32x4 v[4]; float ss = 0.f;
#pragma unroll
            for (int j = 0; j < 4; ++j) { if (BF16IN) { const unsigned lo = (unsigned)nb[j], hi = (unsigned)(nb[j] >> 32); v[j] = (f32x4){pg8::bf_lo(lo), pg8::bf_hi(lo), pg8::bf_lo(hi), pg8::bf_hi(hi)}; } else v[j] = nf[j]; }
            if (rr + 1 < 32) NR_LOAD(row + 1);
#pragma unroll
            for (int j = 0; j < 4; ++j) { ss += (v[j][0] * v[j][0] + v[j][1] * v[j][1]) + (v[j][2] * v[j][2] + v[j][3] * v[j][3]); }
            const float rstd = 1.0f / sqrtf(wave_sum(ss) * (1.0f / DM) + RMS_EPS);
#pragma unroll
            for (int j = 0; j < 4; ++j) v[j] = v[j] * rstd * gs[j] + sh[j];
            if (F32OUT) {
                f32x4* o = (f32x4*)(Fout + (size_t)row * DM) + lane;
#pragma unroll
                for (int j = 0; j < 4; ++j) o[64 * j] = v[j];
            } else {
                unsigned long long* o8 = (unsigned long long*)(Hout + (size_t)row * DM) + lane;
#pragma unroll
                for (int j = 0; j < 4; ++j) o8[64 * j] = (unsigned long long)pk2(v[j][0], v[j][1]) | ((unsigned long long)pk2(v[j][2], v[j][3]) << 32);
            }
            if (FL) {
                float fl[8];
#pragma unroll
                for (int q = 0; q < 8; ++q) fl[q] = 0.f;
#pragma unroll
                for (int q = 0; q < 8; ++q)
#pragma unroll
                    for (int j = 0; j < 4; ++j) { const f32x4 w = *(const f32x4*)(wfl_l + q * DM + 4 * lane + 256 * j); fl[q] += (v[j][0] * w[0] + v[j][1] * w[1]) + (v[j][2] * w[2] + v[j][3] * w[3]); }
                float mine = 0.f;
#pragma unroll
                for (int q = 0; q < 8; ++q) { const float s = wave_sum(fl[q]); if (lane == q) mine = s; }
                if (lane < 8) { const float z = mine + b_fg[lane]; const float lf = fminf(z, 0.f) - log1pf(__expf(-fabsf(z)));
                    logf[((size_t)b * 8 + lane) * S_ + (row & (S_ - 1))] = lf; }
            }
        }
    }
}

#undef NR_LOAD
__device__ __forceinline__ void cumsum_item(const float* logf, float* nbias, int bh, unsigned char* lds_g) {
    float* wsum = (float*)lds_g;
    const int tid = threadIdx.x, wid = tid >> 6, lane = tid & 63;
    const f32x4 v = *(const f32x4*)(logf + (size_t)bh * S_ + 4 * tid);
    const float s1 = v[0], s2 = s1 + v[1], s3 = s2 + v[2], s4 = s3 + v[3];
    float inc = s4;
#pragma unroll
    for (int o = 1; o < 64; o <<= 1) { const float t = __shfl_up(inc, o); if (lane >= o) inc += t; }
    if (lane == 63) wsum[wid] = inc;
    __syncthreads();
    float base = inc - s4;
    for (int w = 0; w < wid; ++w) base += wsum[w];
    const float k = -1.0f / att::SCALE;
    f32x4 o; o[0] = (base + s1) * k; o[1] = (base + s2) * k; o[2] = (base + s3) * k; o[3] = (base + s4) * k;
    *(f32x4*)(nbias + (size_t)bh * S_ + 4 * tid) = o;
    __syncthreads();
}

constexpr int RL_WL = 0, RL_XC = 34816, RL_HS = 69632, RL_WT = 104448, RL_CY = 108544, RL_STR = 272;
template <int NJ>
__device__ __forceinline__ void rnn_item(const Args& a, int item, int cq, unsigned char* lds_g) {
    const int tid = threadIdx.x, wid = __builtin_amdgcn_readfirstlane(tid >> 6), lane = tid & 63, fr = lane & 15, fq = lane >> 4;
    const int b = item / 20, rem = item % 20, n = rem >> 1, c2 = rem & 1, coff = c2 * 64 + cq * 32;
    unsigned char* WL = lds_g + RL_WL; unsigned char* XC = lds_g + RL_XC; float* HS = (float*)(lds_g + RL_HS); float* WT = (float*)(lds_g + RL_WT); float* CY = (float*)(lds_g + RL_CY);
    const bf16* Wa_t = (const bf16*)(a.ws + WS_WA); const bf16* Wi_t = (const bf16*)(a.ws + WS_WI);
    bf16* XR = (bf16*)(a.ws + WS_XR); bf16* GR = (bf16*)(a.ws + WS_GR);
#pragma unroll
    for (int i = 0; i < NJ; ++i) { const int piece = tid + NTHR * i, g = piece / (256 * NJ), pr = (piece >> 4) % (16 * NJ), pc = piece & 15;
        const bf16* src = (g ? Wi_t : Wa_t) + ((size_t)n * 128 + coff + pr) * 128 + pc * 8;
        *(u32x4*)(WL + (g * 16 * NJ + pr) * RL_STR + pc * 16) = *(const u32x4*)src; }
    if (tid < 64) CY[tid] = 0.f;
    constexpr float L2E = 1.4426950408889634f;
    float ba[NJ], bi[NJ], sp8[NJ];
#pragma unroll
    for (int j = 0; j < NJ; ++j) { const int ch = n * 128 + coff + 16 * j + fr; ba[j] = -L2E * a.b_la[ch]; bi[j] = -L2E * a.b_li[ch];
        const float l = -a.lam[ch]; sp8[j] = 8.0f * L2E * (fmaxf(l, 0.f) + log1pf(__expf(-fabsf(l)))); }
    const int cgp = tid & 15, tg = tid >> 4;
    float wcv[4][8], bcv[8];
#pragma unroll
    for (int e = 0; e < 8; ++e) { const int ch = n * 128 + 8 * cgp + e; bcv[e] = a.b_rconv[ch];
#pragma unroll
        for (int k = 0; k < 4; ++k) wcv[k][e] = a.w_rconv[k * DR + ch]; }
    const bf16* xrp = XR + (size_t)b * S_ * DR + n * 128 + 8 * cgp;
    bf16* grp = GR + (size_t)b * S_ * DR + n * 128 + coff;
    u32x4 R[7];
#pragma unroll
    for (int i = 0; i < 7; ++i) { const int t = 4 * tg - 3 + i; R[i] = (t >= 0) ? *(const u32x4*)(xrp + (unsigned)(t * DR)) : (u32x4){0u, 0u, 0u, 0u}; }
    for (int c = 0; c < 16; ++c) {
        const int t0 = 128 * c;
#pragma unroll
        for (int q = 0; q < 4; ++q) {
            typedef float f32x2 __attribute__((ext_vector_type(2)));
            f32x2 y2[4];
#pragma unroll
            for (int p = 0; p < 4; ++p) y2[p] = (f32x2){bcv[2 * p], bcv[2 * p + 1]};
#pragma unroll
            for (int k = 0; k < 4; ++k) { const u32x4 rv = R[q + k];
                const f32x2 x0 = {pg8::bf_lo(rv.x), pg8::bf_hi(rv.x)}, x1 = {pg8::bf_lo(rv.y), pg8::bf_hi(rv.y)}, x2 = {pg8::bf_lo(rv.z), pg8::bf_hi(rv.z)}, x3 = {pg8::bf_lo(rv.w), pg8::bf_hi(rv.w)};
                y2[0] = __builtin_elementwise_fma(x0, (f32x2){wcv[k][0], wcv[k][1]}, y2[0]); y2[1] = __builtin_elementwise_fma(x1, (f32x2){wcv[k][2], wcv[k][3]}, y2[1]);
                y2[2] = __builtin_elementwise_fma(x2, (f32x2){wcv[k][4], wcv[k][5]}, y2[2]); y2[3] = __builtin_elementwise_fma(x3, (f32x2){wcv[k][6], wcv[k][7]}, y2[3]); }
            u32x4 o; o.x = pk2(y2[0][0], y2[0][1]); o.y = pk2(y2[1][0], y2[1][1]); o.z = pk2(y2[2][0], y2[2][1]); o.w = pk2(y2[3][0], y2[3][1]);
            *(u32x4*)(XC + (4 * tg + q) * RL_STR + cgp * 16) = o;
        }
        if (c + 1 < 16) {
#pragma unroll
            for (int i = 0; i < 7; ++i) R[i] = *(const u32x4*)(xrp + (unsigned)((t0 + 128 + 4 * tg - 3 + i) * DR));
        }
        u32x4 G[NJ / 2];
#pragma unroll
        for (int i = 0; i < NJ / 2; ++i) { const int piece = tid + NTHR * i, tok = piece / (2 * NJ), pc = piece % (2 * NJ);
            G[i] = *(const u32x4*)(grp + (unsigned)((t0 + tok) * DR + pc * 8)); }
        __syncthreads();
        f32x4 acc[2][NJ];
#pragma unroll
        for (int g = 0; g < 2; ++g)
#pragma unroll
            for (int j = 0; j < NJ; ++j) acc[g][j] = (f32x4){0.f, 0.f, 0.f, 0.f};
#pragma unroll
        for (int ks = 0; ks < 4; ++ks) {
            const bf16x8 A = *(const bf16x8*)(XC + (16 * wid + fr) * RL_STR + ks * 64 + fq * 16);
#pragma unroll
            for (int g = 0; g < 2; ++g)
#pragma unroll
                for (int j = 0; j < NJ; ++j) { const bf16x8 Bf = *(const bf16x8*)(WL + (g * 16 * NJ + 16 * j + fr) * RL_STR + ks * 64 + fq * 16);
                    acc[g][j] = __builtin_amdgcn_mfma_f32_16x16x32_bf16(A, Bf, acc[g][j], 0, 0, 0); }
        }
        float hl[NJ][4], ac[NJ][4], Ap[NJ], Hp[NJ];
#pragma unroll
        for (int j = 0; j < NJ; ++j) {
            float H = 0.f, A = 1.f;
#pragma unroll
            for (int r = 0; r < 4; ++r) {
                const int tok = 16 * wid + 4 * fq + r;
                const float xcv = __uint_as_float((unsigned)(*(const unsigned short*)(XC + tok * RL_STR + (coff + 16 * j + fr) * 2)) << 16);
                const float ra = __builtin_amdgcn_rcpf(1.0f + __builtin_amdgcn_exp2f(fmaf(acc[0][j][r], -L2E, ba[j]))), ii = __builtin_amdgcn_rcpf(1.0f + __builtin_amdgcn_exp2f(fmaf(acc[1][j][r], -L2E, bi[j])));
                const float av = __builtin_amdgcn_exp2f(-sp8[j] * ra), mult = __builtin_amdgcn_sqrtf(fmaxf(fmaf(-av, av, 1.0f), 0.f));
                const float u = mult * ii * xcv;
                H = av * H + u; A *= av; hl[j][r] = H; ac[j][r] = A;
            }
            float ap = 1.f, hp = 0.f;
#pragma unroll
            for (int q = 0; q < 3; ++q) { const float Aq = __shfl(A, fr + 16 * q), Hq = __shfl(H, fr + 16 * q); if (q < fq) { hp = Aq * hp + Hq; ap *= Aq; } }
            Ap[j] = ap; Hp[j] = hp;
            if (fq == 3) { WT[(wid * 64 + 16 * j + fr) * 2 + 0] = ap * A; WT[(wid * 64 + 16 * j + fr) * 2 + 1] = A * hp + H; }
        }
        __syncthreads();
#pragma unroll
        for (int j = 0; j < NJ; ++j) {
            const int chl = 16 * j + fr;
            float Hc = CY[(c & 1) * 64 + chl];
            for (int w = 0; w < wid; ++w) Hc = WT[(w * 64 + chl) * 2] * Hc + WT[(w * 64 + chl) * 2 + 1];
            const float H0 = Ap[j] * Hc + Hp[j];
            float hv = 0.f;
#pragma unroll
            for (int r = 0; r < 4; ++r) { hv = ac[j][r] * H0 + hl[j][r]; HS[(16 * wid + 4 * fq + r) * 68 + chl] = hv; }
            if (wid == 7 && fq == 3) CY[((c + 1) & 1) * 64 + chl] = hv;
        }
        __syncthreads();
#pragma unroll
        for (int i = 0; i < NJ / 2; ++i) { const int piece = tid + NTHR * i, tok = piece / (2 * NJ), pc = piece % (2 * NJ);
            const f32x4 h0 = *(const f32x4*)(HS + tok * 68 + pc * 8), h1 = *(const f32x4*)(HS + tok * 68 + pc * 8 + 4); const u32x4 gv = G[i];
            u32x4 o; o.x = pk2(gelu_tanh(pg8::bf_lo(gv.x)) * h0[0], gelu_tanh(pg8::bf_hi(gv.x)) * h0[1]); o.y = pk2(gelu_tanh(pg8::bf_lo(gv.y)) * h0[2], gelu_tanh(pg8::bf_hi(gv.y)) * h0[3]);
            o.z = pk2(gelu_tanh(pg8::bf_lo(gv.z)) * h1[0], gelu_tanh(pg8::bf_hi(gv.z)) * h1[1]); o.w = pk2(gelu_tanh(pg8::bf_lo(gv.w)) * h1[2], gelu_tanh(pg8::bf_hi(gv.w)) * h1[3]);
            *(u32x4*)(grp + (unsigned)((t0 + tok) * DR + pc * 8)) = o; }
    }
    __syncthreads();
}

__device__ __forceinline__ void convffn_phase(const Args& a, int gtid, int ngt) {
    const bf16* GF = (const bf16*)(a.ws + WS_GF); bf16* UF = (bf16*)(a.ws + WS_UF);
    constexpr int NCG = DFF / 8, NIT = (T_ / 8) * NCG;
    for (int it = gtid; it < NIT; it += ngt) {
        const int cgp = it % NCG, tg = it / NCG, ch = 8 * cgp, row0 = 8 * tg, t = row0 & (S_ - 1);
        float w0[8], w1[8], w2[8], bb[8];
#pragma unroll
        for (int e = 0; e < 8; e += 4) { const f32x4 t0 = *(const f32x4*)(a.w_fconv + ch + e), t1 = *(const f32x4*)(a.w_fconv + DFF + ch + e), t2 = *(const f32x4*)(a.w_fconv + 2 * DFF + ch + e), t3 = *(const f32x4*)(a.b_fconv + ch + e);
#pragma unroll
            for (int q = 0; q < 4; ++q) { w0[e + q] = t0[q]; w1[e + q] = t1[q]; w2[e + q] = t2[q]; bb[e + q] = t3[q]; } }
        const bf16* gp = GF + (size_t)row0 * DFF + ch; bf16* up = UF + (size_t)row0 * DFF + ch;
        u32x4 g[10];
#pragma unroll
        for (int i = 0; i < 10; ++i) g[i] = (t + i - 2 >= 0) ? *(const u32x4*)(gp + (ptrdiff_t)(i - 2) * DFF) : (u32x4){0u, 0u, 0u, 0u};
#pragma unroll
        for (int r = 0; r < 8; ++r) {
            const u32x4 uv = *(const u32x4*)(up + (size_t)r * DFF);
            const u32x4 ga = g[r], gb = g[r + 1], gc = g[r + 2];
            float y[8];
#define CV(e, A_, B_, C_) y[e] = gelu_tanh(bb[e] + w0[e] * (A_) + w1[e] * (B_) + w2[e] * (C_))
            CV(0, pg8::bf_lo(ga.x), pg8::bf_lo(gb.x), pg8::bf_lo(gc.x)); CV(1, pg8::bf_hi(ga.x), pg8::bf_hi(gb.x), pg8::bf_hi(gc.x));
            CV(2, pg8::bf_lo(ga.y), pg8::bf_lo(gb.y), pg8::bf_lo(gc.y)); CV(3, pg8::bf_hi(ga.y), pg8::bf_hi(gb.y), pg8::bf_hi(gc.y));
            CV(4, pg8::bf_lo(ga.z), pg8::bf_lo(gb.z), pg8::bf_lo(gc.z)); CV(5, pg8::bf_hi(ga.z), pg8::bf_hi(gb.z), pg8::bf_hi(gc.z));
            CV(6, pg8::bf_lo(ga.w), pg8::bf_lo(gb.w), pg8::bf_lo(gc.w)); CV(7, pg8::bf_hi(ga.w), pg8::bf_hi(gb.w), pg8::bf_hi(gc.w));
#undef CV
            u32x4 o; o.x = pk2(y[0] * pg8::bf_lo(uv.x), y[1] * pg8::bf_hi(uv.x)); o.y = pk2(y[2] * pg8::bf_lo(uv.y), y[3] * pg8::bf_hi(uv.y));
            o.z = pk2(y[4] * pg8::bf_lo(uv.z), y[5] * pg8::bf_hi(uv.z)); o.w = pk2(y[6] * pg8::bf_lo(uv.w), y[7] * pg8::bf_hi(uv.w));
            *(u32x4*)(up + (size_t)r * DFF) = o;
        }
    }
}

__device__ __forceinline__ att::BlockRef att_mkref(int L_, int pass_, bf16* QB_, const bf16* KB_, const bf16* VB_, const float* NBI) {
    const int bh = L_ >> 2, x = L_ & 3, qb = pass_ ? 7 - x : x, b = bh >> 3, h = bh & 7;
    att::BlockRef r; const size_t ro = ((size_t)b * S_ + (size_t)qb * 256) * DM + h * 128;
    r.Q = QB_ + ro; r.O = QB_ + ro; r.K = KB_ + (size_t)b * S_ * DM + h * 128; r.V = VB_ + (size_t)b * S_ * DM + h * 128; r.NB = NBI + (size_t)bh * S_; r.P0 = qb * 256; return r;
}
#define PHASE_PTRS() size_t zo_ = 0; asm volatile("" : "+s"(zo_)); unsigned char* wsl = a.ws + zo_;     \
    bf16* Win_t = (bf16*)(wsl + WS_WIN); bf16* Wup_t = (bf16*)(wsl + WS_WUP); bf16* Wdn_t = (bf16*)(wsl + WS_WDN); bf16* Wpr_t = (bf16*)(wsl + WS_WPR); \
    bf16* Wpa_t = (bf16*)(wsl + WS_WPA); bf16* Wout_t = (bf16*)(wsl + WS_WOUT); bf16* Wa_t = (bf16*)(wsl + WS_WA); bf16* Wi_t = (bf16*)(wsl + WS_WI); \
    float* MOD = (float*)(wsl + WS_MOD); float* MODF = (float*)(wsl + WS_MODF); float* NBI = (float*)(wsl + WS_NB); float* LOGF = (float*)(wsl + WS_LOGF); \
    bf16* HB = (bf16*)(wsl + WS_H); bf16* XR = (bf16*)(wsl + WS_XR); bf16* GR = (bf16*)(wsl + WS_GR); bf16* QB_ = (bf16*)(wsl + WS_Q); bf16* KB_ = (bf16*)(wsl + WS_K); bf16* VB_ = (bf16*)(wsl + WS_V); \
    bf16* GF = (bf16*)(wsl + WS_GF); bf16* UF = (bf16*)(wsl + WS_UF); float* outl = a.out + zo_; bf16* MG = (bf16*)outl; \
    (void)Win_t; (void)Wup_t; (void)Wdn_t; (void)Wpr_t; (void)Wpa_t; (void)Wout_t; (void)Wa_t; (void)Wi_t; (void)MOD; (void)MODF; (void)NBI; (void)LOGF; (void)HB; (void)XR; (void)GR; (void)QB_; (void)KB_; (void)VB_; (void)GF; (void)UF; (void)MG
static_assert(att::LDS_BYTES <= LDS_BYTES - 64, "attention LDS map");
constexpr int NPH = 11;
__global__ void __launch_bounds__(NTHR, 2) fwd_mega(Args a) {
    extern __shared__ __attribute__((aligned(16))) unsigned char lds[];
    LAS unsigned char* lds3 = (LAS unsigned char*)lds;
    const int tid = threadIdx.x, lane = tid & 63, wave = __builtin_amdgcn_readfirstlane(tid >> 6);
    const int G = gridDim.x, bx = blockIdx.x;
    const int vcu = (G % 8 == 0) ? (bx % 8) * (G / 8) + bx / 8 : bx;
    const int gw = vcu * NWV + wave, ngw = G * NWV;
    unsigned char* ws = a.ws;
    const int lo = a.ph_lo, hi = a.ph_hi;
    const bool use_cg = a.use_cg != 0;
    if (tid < 16) ((LAS unsigned*)(lds3 + MISC_OFF))[tid] = 0u;
    __syncthreads();
    const XcdBarrier bar = xcd_barrier_post((unsigned*)ws, (volatile LAS unsigned*)(lds3 + MISC_OFF));
#ifndef PH_MASK
#define PH_MASK 0xFFFF
#endif
#define IN(k) (lo <= (k) && (k) < hi && ((PH_MASK >> (k)) & 1))
#ifndef PROBE_MASK
#define PROBE_MASK 0
#endif
    unsigned long long t_prev = 0; if (PROBE_MASK) t_prev = __builtin_amdgcn_s_memrealtime();
#define PROBE_AFTER(k) do { if (PROBE_MASK) { const unsigned long long t_now = __builtin_amdgcn_s_memrealtime(); if ((PROBE_MASK >> (k)) & 1) { const unsigned long long d_ = t_now - t_prev; \
        while (__builtin_amdgcn_s_memrealtime() - t_now < d_) __builtin_amdgcn_s_sleep(8); xcd_barrier(bar); } t_prev = __builtin_amdgcn_s_memrealtime(); } } while (0)
#define SEAM(k) do { if (IN(k) && IN((k) + 1)) { if (use_cg) cg::this_grid().sync(); else xcd_barrier(bar); PROBE_AFTER(k); } } while (0)

    if (IN(0)) { PHASE_PTRS();
        for (int it = bx; it < 256; it += G) mod_item(a, it, lds);
        LAS float* scr = (LAS float*)(lds3 + wave * 16384);
        struct TD { const float* W; int ldw, col0, ncols, K; bf16* WT; int row0; };
        const TD td[7] = {
            {a.w_in, DIN, 0, ZC_FL, DM, Win_t, 0}, {a.w_in, DIN, ZC_MG, 2 * DM, DM, Win_t, ZC_FL}, {a.w_pr, DM, 0, DM, DR, Wpr_t, 0}, {a.w_pa, DM, 0, DM, DM, Wpa_t, 0},
            {a.w_out, DM, 0, DM, DM, Wout_t, 0}, {a.w_dn, DM, 0, DM, DFF, Wdn_t, 0}, {a.w_dn, DM, 0, 0, DFF, Wdn_t, 0} };
        int base = 0;
#pragma unroll
        for (int m = 0; m < 7; ++m) { const int nblk = td[m].ncols / 32, nit = (td[m].K / 64) * nblk;
            int first = (gw - base) % ngw; if (first < 0) first += ngw;
            for (int it = first; it < nit; it += ngw) transpose_item(td[m].W, td[m].ldw, td[m].col0, td[m].WT, td[m].K, td[m].row0, nblk, scr, it, lane);
            base += nit; }
        for (int it = gw; it < 16 * 192; it += ngw) { const int nb = it % 192, c = 32 * nb, ch = c < DFF ? c : c - DFF, row = 256 * (ch >> 7) + (c < DFF ? 0 : 128) + (ch & 127);
            transpose_item(a.w_up, 2 * DFF, 0, Wup_t, DM, row - c, 192, scr, it, lane); }
        for (int it = gw; it < 160; it += ngw) { const int g = it / 80, r = it % 80, n = r >> 3, sub = r & 7;
            transpose_item((g ? a.w_li : a.w_la) + (size_t)n * 16384, 128, 0, (g ? Wi_t : Wa_t) + (size_t)n * 16384, 128, 0, 4, scr, sub, lane); }
    }
    SEAM(0);
#ifndef NO_P1
    if (IN(1)) { PHASE_PTRS(); norm_rows<true, false>(a.x, a.g1, MOD + 0 * DM, MOD + 1 * DM, 6 * DM, HB, nullptr, a.w_in, a.b_fg, LOGF, gw, ngw, (float*)lds); }
#endif
    SEAM(1);
    if (IN(2)) { PHASE_PTRS();
        for (int bh = bx; bh < NB_ * 8; bh += G) cumsum_item(LOGF, NBI, bh, lds);
        __syncthreads();
        { pg8::Gemm g{HB, Win_t, T_, 6144, DM, (unsigned*)(wsl + 128 * 1024)}; pg8::StaticOrder S; S.init(T_, 6144, G, bx);
          pg8::EpiB<0, 0> E{}; E.ws = wsl; E.mg = MG; E.gcol = 0;
          pg8::gemm_phase<pg8::EpiB<0, 0>, pg8::StaticOrder, true, true>(lds3, g, S, E); }
        { pg8::Gemm g{HB, Win_t + (size_t)6144 * DM, T_, NZ - 6144, DM, (unsigned*)(wsl + 128 * 1024)}; pg8::StaticOrder S; S.init(T_, NZ - 6144, G, bx);
          pg8::EpiB<0, 0> E{}; E.ws = wsl; E.mg = MG; E.gcol = 24;
          pg8::gemm_phase<pg8::EpiB<0, 0>, pg8::StaticOrder, true, true>(lds3, g, S, E); }
    }
    SEAM(2);
    if (IN(3)) { PHASE_PTRS();
#ifndef NO_RNN
        for (int it = vcu; it < 512; it += G) rnn_item<4>(a, it, 0, lds);
        for (int q = vcu; q < 256; q += G) rnn_item<2>(a, 512 + (q >> 1), q & 1, lds);
#endif
        __syncthreads();
        if ((PROBE_MASK >> 11) & 3) { xcd_barrier(bar); PROBE_AFTER(11); }
        const int total = NB_ * 8 * 4;
#ifndef NO_ATT
        if (vcu < total) {
            att::Seam S;
            int L = vcu, pass = 0;
#define mkref(L_, pass_) att_mkref((L_), (pass_), QB_, KB_, VB_, NBI)
            att::BlockRef cur = mkref(L, 0);
            att::prime(cur, (char*)lds, S);
            for (;;) {
                const bool more_pass = pass == 0, more_item = L + G < total, last = !more_pass && !more_item;
                int Ln = L, passn = pass + 1;
                if (!more_pass) { passn = 0; Ln = more_item ? L + G : L; }
                const att::BlockRef nxt = last ? cur : mkref(Ln, passn);
                att::block(cur, nxt, (char*)lds, S);
                if (last) break;
                cur = nxt; pass = passn; L = Ln;
            }
        }
#endif
    }
    SEAM(3);
    if (IN(4)) { PHASE_PTRS();
        __syncthreads();
        { pg8::Gemm g{GR, Wpr_t, T_, DM, DR, (unsigned*)(wsl + 128 * 1024)}; pg8::StaticOrder S; S.init(T_, DM, G, bx);
          pg8::EpiB<1> E{}; E.s0 = HB; E.l0 = DM; E.G = MG; E.g_ld = 2 * DM; E.gcol = 0;
          pg8::gemm_phase<pg8::EpiB<1>, pg8::StaticOrder, true, true>(lds3, g, S, E); }
        { pg8::Gemm g{QB_, Wpa_t, T_, DM, DM, (unsigned*)(wsl + 128 * 1024)}; pg8::StaticOrder S; S.init(T_, DM, G, bx);
          pg8::EpiB<2> E{}; E.s0 = HB; E.l0 = DM; E.G = MG; E.g_ld = 2 * DM; E.gcol = DM;
          pg8::gemm_phase<pg8::EpiB<2>, pg8::StaticOrder, true, true>(lds3, g, S, E); }
    }
    SEAM(4);
    if (IN(5)) { PHASE_PTRS();
        pg8::Gemm g{HB, Wout_t, T_, DM, DM, (unsigned*)(wsl + 128 * 1024)}; pg8::StaticOrder S; S.init(T_, DM, G, bx);
        pg8::EpiResB<false> E{a.x, GR, MOD + 2 * DM, 6 * DM, DM};
        pg8::gemm_phase<pg8::EpiResB<false>, pg8::StaticOrder, true, true>(lds3, g, S, E);
    }
    SEAM(5);
    if (IN(6)) { PHASE_PTRS(); norm_rows<false, false, true>((const float*)GR, a.g2, MOD + 3 * DM, MOD + 4 * DM, 6 * DM, HB, nullptr, nullptr, nullptr, nullptr, gw, ngw, nullptr); }
    SEAM(6);
    if (IN(7)) { PHASE_PTRS();
        pg8::Gemm g{HB, Wup_t, T_, 2 * DFF, DM, (unsigned*)(wsl + 128 * 1024)}; pg8::StaticOrder S; S.init(T_, 2 * DFF, G, bx);
        pg8::EpiConv E{UF, a.w_fconv, a.b_fconv, (float*)(wsl + WS_PRE), (float*)(wsl + WS_UF2), (float*)(wsl + WS_GL), (LAS float*)(lds3 + 131072)};
        pg8::gemm_phase<pg8::EpiConv, pg8::StaticOrder, true, true>(lds3, g, S, E);
    }
    SEAM(7);
    if (IN(8)) { PHASE_PTRS();
        const float* PRE = (const float*)(wsl + WS_PRE); const float* UF2 = (const float*)(wsl + WS_UF2); const float* GL = (const float*)(wsl + WS_GL);
        for (int e = (vcu * NTHR + tid) * 4; e < 256 * 2 * DFF; e += G * NTHR * 4) {
            const int ch = e % DFF, r = (e / DFF) & 1, pm = e / (2 * DFF);
            if ((pm & 7) == 0) continue;
            const f32x4 p = *(const f32x4*)(PRE + e), uu = *(const f32x4*)(UF2 + e);
            const f32x4 ga = *(const f32x4*)(GL + ((size_t)((pm - 1) * 2 + 0)) * DFF + ch), gb = *(const f32x4*)(GL + ((size_t)((pm - 1) * 2 + 1)) * DFF + ch);
            const f32x4 w0 = *(const f32x4*)(a.w_fconv + ch), w1 = *(const f32x4*)(a.w_fconv + DFF + ch);
            f32x4 y;
#pragma unroll
            for (int i = 0; i < 4; ++i) { const float pr = p[i] + (r == 0 ? w1[i] * gb[i] + w0[i] * ga[i] : w0[i] * gb[i]); y[i] = gelu_tanh(pr) * uu[i]; }
            *(unsigned long long*)(UF + ((size_t)pm * 256 + r) * DFF + ch) = (unsigned long long)pk2(y[0], y[1]) | ((unsigned long long)pk2(y[2], y[3]) << 32);
        }
    }
    SEAM(8);
    if (IN(9)) { PHASE_PTRS();
        pg8::Gemm g{UF, Wdn_t, T_, DM, DFF, (unsigned*)(wsl + 128 * 1024)}; pg8::StaticOrder S; S.init(T_, DM, G, bx);
        pg8::EpiResB<true> E{GR, GR, MOD + 5 * DM, 6 * DM, DM};
        pg8::gemm_phase<pg8::EpiResB<true>, pg8::StaticOrder, true, true>(lds3, g, S, E);
    }
    SEAM(9);
    if (IN(10)) { PHASE_PTRS(); norm_rows<false, true, true>((const float*)GR, a.gfin, MODF + 0, MODF + DM, 2 * DM, nullptr, outl, nullptr, nullptr, nullptr, gw, ngw, nullptr); }
#ifdef PROBE_SYNCS
#pragma unroll 1
    for (int i_ = 0; i_ < PROBE_SYNCS; ++i_) xcd_barrier(bar);
#endif
#undef IN
#undef SEAM
}

#ifndef MK_N_LAUNCHES
#define MK_N_LAUNCHES 1
#endif
extern "C" void kernel_launch(void* const* d_in, const int* in_sizes, int n_in, void* d_out, int out_size, void* d_ws, size_t ws_size, hipStream_t stream) {
    static int grid = 0;
    if (grid == 0) {
        if (n_in != 25 || in_sizes[0] != T_ * DM || out_size != T_ * DM || ws_size < WS_END) {
            fprintf(stderr, "kernel_launch: unexpected shapes (n_in %d, in0 %d, out %d, ws %zu); nothing launched\n", n_in, n_in > 0 ? in_sizes[0] : -1, out_size, ws_size); grid = -1; return; }
        int dev = 0, cus = 0, per_cu = 0;
        (void)hipGetDevice(&dev); (void)hipDeviceGetAttribute(&cus, hipDeviceAttributeMultiprocessorCount, dev);
        if (hipFuncSetAttribute((const void*)fwd_mega, hipFuncAttributeMaxDynamicSharedMemorySize, LDS_BYTES) != hipSuccess) { fprintf(stderr, "kernel_launch: hipFuncSetAttribute failed\n"); grid = -1; return; }
        if (hipOccupancyMaxActiveBlocksPerMultiprocessor(&per_cu, (const void*)fwd_mega, NTHR, LDS_BYTES) != hipSuccess || per_cu < 1) { fprintf(stderr, "kernel_launch: occupancy query says %d\n", per_cu); per_cu = 1; }
        (void)hipGetLastError();
        grid = cus > 0 ? cus : 256;
    }
    if (grid < 0) return;
    Args a{};
    const float** f = (const float**)&a;
    for (int i = 0; i < 25; ++i) f[i] = (const float*)d_in[i];
    a.out = (float*)d_out; a.ws = (unsigned char*)d_ws;
    if (hipMemsetAsync(d_ws, 0, CTL_ZERO_BYTES, stream) != hipSuccess) { fprintf(stderr, "kernel_launch: hipMemsetAsync failed\n"); return; }
    if (MK_N_LAUNCHES == 1) {
        a.ph_lo = 0; a.ph_hi = NPH;
        void* args[] = {&a};
        const hipError_t e = hipLaunchCooperativeKernel((const void*)fwd_mega, dim3(grid), dim3(NTHR), args, LDS_BYTES, stream);
        if (e != hipSuccess) fprintf(stderr, "kernel_launch: cooperative launch failed: %s (grid %d)\n", hipGetErrorString(e), grid);
    } else {
        for (int p = 0; p < NPH; ++p) { a.ph_lo = p; a.ph_hi = p + 1; hipLaunchKernelGGL(fwd_mega, dim3(grid), dim3(NTHR), LDS_BYTES, stream, a); }
    }
}
```
